# Optimizing an MI355X kernel written in HIP

```python
import math
import jax, jax.numpy as jnp
from jax import lax
import numpy as np

D_MODEL = 2048
BATCH = 8
SEQ = 2048
DEPTH = 1

HEAD_DIM = 64
LRU_WIDTH = D_MODEL // 2
LRU_HEADS = LRU_WIDTH // HEAD_DIM
LRU_HEAD_DIM = HEAD_DIM
ATTN_WIDTH = D_MODEL - LRU_WIDTH
ATTN_HEADS = ATTN_WIDTH // HEAD_DIM
ATTN_HEAD_DIM = HEAD_DIM
MIX_WIDTH = LRU_WIDTH + ATTN_WIDTH
IN_PROJ_WIDTH = 2 * LRU_WIDTH + 3 * ATTN_WIDTH
CONV_WIDTH = 4
RG_C = 8.0
GRID_W = 64
WIN_ROWS = 8
WIN_COLS = 16
D_FF = 256 * math.ceil(8 * D_MODEL / 3 / 256)
NORM_EPS = 1e-6

kernel_name = "hybrid_rglru_natten_macaron"


def rms_norm(x, g):
    xf = x.astype(jnp.float32)
    y = xf * lax.rsqrt(jnp.mean(xf * xf, axis=-1, keepdims=True) + NORM_EPS) * g.astype(jnp.float32)
    return y.astype(x.dtype)


def swiglu(u, w_in, w_out):
    gate, up = jnp.split(u @ w_in, 2, axis=-1)
    return (jax.nn.silu(gate) * up) @ w_out


def _lin_rec_combine(left, right):
    a_l, b_l = left
    a_r, b_r = right
    return a_l * a_r, a_r * b_l + b_r


def rglru_mixer(x_in, gate_in, conv_w, conv_b, gate_w, gate_b, lam):
    B, S, C = x_in.shape
    pad_l = CONV_WIDTH // 2
    xc = lax.conv_general_dilated(
        x_in, conv_w[:, None, :], window_strides=(1,),
        padding=[(pad_l, CONV_WIDTH - 1 - pad_l)],
        dimension_numbers=("NWC", "WIO", "NWC"), feature_group_count=C) + conv_b
    xf = xc.astype(jnp.float32)
    xh = xf.reshape(B, S, LRU_HEADS, LRU_HEAD_DIM)
    gates = jax.nn.sigmoid(
        jnp.einsum("bshi,zghij->zgbshj", xh, gate_w.astype(jnp.float32))
        + gate_b.astype(jnp.float32)[:, :, None, None])
    gates = gates.reshape(2, 2, B, S, C)
    r, i = gates[:, 0], gates[:, 1]
    log_a = -RG_C * r * jax.nn.softplus(-lam.astype(jnp.float32))[:, None, None, :]
    a = jnp.exp(log_a)
    b = jnp.sqrt(-jnp.expm1(2.0 * log_a)) * (i * xf)
    h_fwd = lax.associative_scan(_lin_rec_combine, (a[0], b[0]), axis=1)[1]
    h_bwd = lax.associative_scan(_lin_rec_combine, (a[1], b[1]), axis=1, reverse=True)[1]
    y = jax.nn.gelu(gate_in.astype(jnp.float32)) * (h_fwd + h_bwd)
    return y.astype(x_in.dtype)


def neighbourhood_attention(q, k, v, rpb):
    B, S, _ = q.shape
    rows = S // GRID_W
    kr = min(WIN_ROWS, rows)
    grid = (B, rows, GRID_W, ATTN_HEADS, ATTN_HEAD_DIM)
    scale = ATTN_HEAD_DIM ** -0.5
    qg = q.reshape(grid).astype(jnp.float32) * scale
    kg = k.reshape(grid).astype(jnp.float32)
    vg = v.reshape(grid).astype(jnp.float32)
    cols = jnp.arange(GRID_W)
    col_start = jnp.clip(cols - WIN_COLS // 2, 0, GRID_W - WIN_COLS)
    col_idx = col_start[:, None] + jnp.arange(WIN_COLS)
    sel = jax.nn.one_hot(col_idx, GRID_W, dtype=jnp.float32)
    col_bias = rpb.astype(jnp.float32)[:, :, col_idx - cols[:, None] + WIN_COLS - 1]

    def row_block(r):
        rs = jnp.clip(r - kr // 2, 0, rows - kr)
        q_row = lax.dynamic_index_in_dim(qg, r, axis=1, keepdims=False)
        k_band = lax.dynamic_slice_in_dim(kg, rs, kr, axis=1)
        v_band = lax.dynamic_slice_in_dim(vg, rs, kr, axis=1)
        s_band = jnp.einsum("bqhd,brkhd->bhqrk", q_row, k_band)
        s = jnp.einsum("bhqrk,qwk->bhqrw", s_band, sel)
        row_off = rs + jnp.arange(kr) - r + WIN_ROWS - 1
        bias = jnp.take(col_bias, row_off, axis=1).transpose(0, 2, 1, 3)
        s = s + bias[None]
        p = jax.nn.softmax(s.reshape(B, ATTN_HEADS, GRID_W, kr * WIN_COLS), axis=-1)
        p = p.reshape(B, ATTN_HEADS, GRID_W, kr, WIN_COLS)
        p_band = jnp.einsum("bhqrw,qwk->bhqrk", p, sel)
        return jnp.einsum("bhqrk,brkhd->bqhd", p_band, v_band)

    out = lax.map(row_block, jnp.arange(rows))
    return out.transpose(1, 0, 2, 3, 4).reshape(B, S, ATTN_WIDTH).astype(q.dtype)


def setup_inputs(seed: int = 0) -> dict:
    key = jax.random.key(seed)
    ks = jax.random.split(key, 24)
    f32 = jnp.float32
    L = DEPTH

    def nrm(k, shape, scale):
        return jax.random.normal(k, shape, f32) * scale

    def gain(k, shape):
        return 1.0 + 0.05 * jax.random.normal(k, shape, f32)

    a_c = jax.random.uniform(ks[10], (L, 2, LRU_WIDTH), f32, 0.9, 0.999)
    a_base = a_c ** (1.0 / RG_C)
    lru_lambda = jnp.log(a_base) - jnp.log1p(-a_base)
    return {
        "x": nrm(ks[0], (BATCH, SEQ, D_MODEL), 1.0),
        "norm_ffn1": gain(ks[1], (L, D_MODEL)),
        "ffn1_w_in": nrm(ks[2], (L, D_MODEL, 2 * D_FF), D_MODEL ** -0.5),
        "ffn1_w_out": nrm(ks[3], (L, D_FF, D_MODEL), D_FF ** -0.5),
        "norm_mix": gain(ks[4], (L, D_MODEL)),
        "w_in_mix": nrm(ks[5], (L, D_MODEL, IN_PROJ_WIDTH), D_MODEL ** -0.5),
        "lru_conv_w": nrm(ks[6], (L, CONV_WIDTH, LRU_WIDTH), CONV_WIDTH ** -0.5),
        "lru_conv_b": nrm(ks[7], (L, LRU_WIDTH), 0.01),
        "lru_gate_w": nrm(ks[8], (L, 2, 2, LRU_HEADS, LRU_HEAD_DIM, LRU_HEAD_DIM), LRU_HEAD_DIM ** -0.5),
        "lru_gate_b": nrm(ks[9], (L, 2, 2, LRU_HEADS, LRU_HEAD_DIM), 0.01),
        "lru_lambda": lru_lambda,
        "attn_rpb": nrm(ks[11], (L, ATTN_HEADS, 2 * WIN_ROWS - 1, 2 * WIN_COLS - 1), 0.02),
        "lru_out_norm": gain(ks[12], (L, LRU_WIDTH)),
        "attn_out_norm": gain(ks[13], (L, ATTN_WIDTH)),
        "w_out_mix": nrm(ks[14], (L, MIX_WIDTH, D_MODEL), MIX_WIDTH ** -0.5),
        "norm_ffn2": gain(ks[15], (L, D_MODEL)),
        "ffn2_w_in": nrm(ks[16], (L, D_MODEL, 2 * D_FF), D_MODEL ** -0.5),
        "ffn2_w_out": nrm(ks[17], (L, D_FF, D_MODEL), D_FF ** -0.5),
        "norm_final": gain(ks[18], (D_MODEL,)),
    }


def reference(x, norm_ffn1, ffn1_w_in, ffn1_w_out, norm_mix, w_in_mix, lru_conv_w, lru_conv_b,
              lru_gate_w, lru_gate_b, lru_lambda, attn_rpb, lru_out_norm, attn_out_norm,
              w_out_mix, norm_ffn2, ffn2_w_in, ffn2_w_out, norm_final):
    h = x
    for l in range(DEPTH):
        h = h + 0.5 * swiglu(rms_norm(h, norm_ffn1[l]), ffn1_w_in[l], ffn1_w_out[l])
        u = rms_norm(h, norm_mix[l])
        proj = u @ w_in_mix[l]
        x_lru, g_lru, q, k, v = jnp.split(
            proj, [LRU_WIDTH, 2 * LRU_WIDTH, 2 * LRU_WIDTH + ATTN_WIDTH,
                   2 * LRU_WIDTH + 2 * ATTN_WIDTH], axis=-1)
        y_a = rglru_mixer(x_lru, g_lru, lru_conv_w[l], lru_conv_b[l], lru_gate_w[l],
                          lru_gate_b[l], lru_lambda[l])
        y_b = neighbourhood_attention(q, k, v, attn_rpb[l])
        y = jnp.concatenate([rms_norm(y_a, lru_out_norm[l]), rms_norm(y_b, attn_out_norm[l])], axis=-1)
        h = h + y @ w_out_mix[l]
        h = h + 0.5 * swiglu(rms_norm(h, norm_ffn2[l]), ffn2_w_in[l], ffn2_w_out[l])
    return rms_norm(h, norm_final)
```

```cpp
#include <hip/hip_runtime.h>
#include <hip/hip_cooperative_groups.h>
#include <cstdio>
#include <cstdint>
#include <cmath>
namespace cg = cooperative_groups;
namespace pg8 {
#define PG8_LAS __attribute__((address_space(3)))
typedef unsigned short bf16_t;
typedef short bf16x8 __attribute__((ext_vector_type(8)));
typedef float f32x4 __attribute__((ext_vector_type(4)));
typedef unsigned u32x4 __attribute__((ext_vector_type(4)));
constexpr int BM = 256, BK = 64, HALF = 128, HTB = HALF * BK * 2  , STAGE_BYTES = 8 * HTB, NXCD = 8, WGM = 8;

__host__ __device__ __forceinline__ int lds_byte(int r, int c) { const int st = (r >> 4) * 2 + (c >> 5), rr = r & 15, cc = c & 31, ob = rr * 64 + cc * 2; return st * 1024 + (ob ^ (((ob >> 9) & 1) << 5)); }
__host__ __device__ __forceinline__ void stage_rc(int b, int& R, int& C) { const int st = b / 1024, sb = b % 1024, swz = sb ^ (((sb >> 9) & 1) << 5); R = (st >> 1) * 16 + swz / 64; C = (st & 1) * 32 + (swz % 64) / 2; }
__host__ __device__ __forceinline__ int perm32(int rho) { const int n = rho >> 4, i = rho & 15; return 8 * (i >> 2) + 4 * n + (i & 3); }

struct Unit { int pm, pn; };
struct Gemm { const bf16_t* A; const bf16_t* Bt; int M, N, K; };

struct StaticOrder {
    int nM, nN, nwg, G, c;
    __host__ __device__ void init(int M, int N, int G_, int c_) { nM = M / BM; nN = N / BM; nwg = nM * nN; G = G_; c = c_; }
    __host__ __device__ bool next(int i, Unit& u) const {
        const long L = (long)i * G + c; if (L >= nwg) return false;
        int wgid = (int)L; { const int q = nwg / NXCD, r = nwg % NXCD, xcd = wgid % NXCD, off = wgid / NXCD; wgid = (xcd < r ? xcd * (q + 1) : r * (q + 1) + (xcd - r) * q) + off; }
        const int nig = WGM * nN, gid = wgid / nig, fm = gid * WGM, gsz = (nM - fm) < WGM ? (nM - fm) : WGM;
        u.pm = fm + ((wgid % nig) % gsz); u.pn = (wgid % nig) / gsz; return true;
    }
    __device__ __forceinline__ void a_ready(const Unit&) const {}
    __device__ __forceinline__ void done(const Unit&) const {}
};

__device__ __forceinline__ unsigned cvt_pk_bf16(float lo, float hi) { unsigned r; asm volatile("v_cvt_pk_bf16_f32 %0, %1, %2" : "=v"(r) : "v"(lo), "v"(hi)); return r; }
typedef float f32x2 __attribute__((ext_vector_type(2)));
typedef unsigned u32x2 __attribute__((ext_vector_type(2)));
constexpr float RMS_EPS = 1e-6f;
__device__ __forceinline__ float rstd_of(float ss, float inv_n) { return 1.0f / sqrtf(ss * inv_n + RMS_EPS); }
__device__ __forceinline__ float silu_f(float g) { return g * __builtin_amdgcn_rcpf(1.0f + __expf(-g)); }

struct EpiSwiGLU {
    static constexpr bool PERM = true, AFTER_DRAIN = false, HAS_MID = false;
    const float* ss; bf16_t* O; int ldo;
    __device__ __forceinline__ void mid(f32x4 (&)[2][2][4][2], const Unit&, int, int) const {}
    __device__ __forceinline__ void operator()(const f32x4 (&acc)[2][2][4][2], const Unit& u, int wr, int wc, int fr, int fq) const {
        const int row0 = u.pm * BM + wr * 64 + fr; const int col0 = u.pn * HALF + wc * 32 + 8 * fq;
#pragma unroll
        for (int ai = 0; ai < 2; ++ai)
#pragma unroll
            for (int m = 0; m < 4; ++m) {
                const int row = row0 + ai * HALF + m * 16;
                const float rs = rstd_of(ss[row], 1.0f / 2048.0f);
                float v[8];
#pragma unroll
                for (int n = 0; n < 2; ++n)
#pragma unroll
                    for (int e = 0; e < 4; ++e) { const float g = acc[ai][0][m][n][e] * rs, up = acc[ai][1][m][n][e] * rs; v[n * 4 + e] = silu_f(g) * up; }
                u32x4 w; w.x = cvt_pk_bf16(v[0], v[1]); w.y = cvt_pk_bf16(v[2], v[3]); w.z = cvt_pk_bf16(v[4], v[5]); w.w = cvt_pk_bf16(v[6], v[7]);
                *(u32x4*)(O + (size_t)row * ldo + col0) = w;
            }
    }
};

struct EpiProj {
    static constexpr bool PERM = true, AFTER_DRAIN = false, HAS_MID = false;
    const float* ss; bf16_t* base;
    __device__ __forceinline__ void mid(f32x4 (&)[2][2][4][2], const Unit&, int, int) const {}
    __device__ __forceinline__ void operator()(const f32x4 (&acc)[2][2][4][2], const Unit& u, int wr, int wc, int fr, int fq) const {
        const int seg = u.pn >> 2; const int colt = (u.pn & 3) * BM + wc * 32 + 8 * fq;
        const int row0 = u.pm * BM + wr * 64 + fr;
        const float qs = (seg == 2) ? 0.125f : 1.0f;
        bf16_t* op = base + (size_t)seg * ((size_t)16384 * 1024) + (size_t)row0 * 1024 + colt;
#pragma unroll
        for (int ai = 0; ai < 2; ++ai)
#pragma unroll
            for (int m = 0; m < 4; ++m) {
                const int row = row0 + ai * HALF + m * 16;
                const float rs = rstd_of(ss[row], 1.0f / 2048.0f) * qs;
#pragma unroll
                for (int bj = 0; bj < 2; ++bj) {
                    const f32x4 v0 = acc[ai][bj][m][0] * rs, v1 = acc[ai][bj][m][1] * rs;
                    u32x4 w; w.x = cvt_pk_bf16(v0[0], v0[1]); w.y = cvt_pk_bf16(v0[2], v0[3]); w.z = cvt_pk_bf16(v1[0], v1[1]); w.w = cvt_pk_bf16(v1[2], v1[3]);
                    *(u32x4*)(op + (size_t)(ai * HALF + m * 16) * 1024 + bj * HALF) = w;
                }
                asm volatile("" ::: "memory");
            }
    }
};
struct EpiVT {
    static constexpr bool PERM = true, AFTER_DRAIN = false, HAS_MID = false;
    const float* ss; bf16_t* vT;
    __device__ __forceinline__ void mid(f32x4 (&)[2][2][4][2], const Unit&, int, int) const {}
    __device__ __forceinline__ void operator()(const f32x4 (&acc)[2][2][4][2], const Unit& u, int wr, int wc, int fr, int fq) const {
        const int tok0 = u.pn * BM + wc * 32 + 8 * fq;
        const int b = tok0 >> 11, s0 = tok0 & 2047;
        const int ch0 = u.pm * BM + wr * 64 + fr;
        bf16_t* op = vT + ((size_t)(b * 1024 + ch0)) * 2048 + s0;
#pragma unroll
        for (int bj = 0; bj < 2; ++bj) {
            const f32x4 s_lo = *(const f32x4*)(ss + tok0 + bj * HALF), s_hi = *(const f32x4*)(ss + tok0 + bj * HALF + 4);
            float rs[8];
#pragma unroll
            for (int e = 0; e < 4; ++e) { rs[e] = rstd_of(s_lo[e], 1.0f / 2048.0f); rs[4 + e] = rstd_of(s_hi[e], 1.0f / 2048.0f); }
#pragma unroll
            for (int ai = 0; ai < 2; ++ai)
#pragma unroll
                for (int m = 0; m < 4; ++m) {
                    const f32x4 v0 = acc[ai][bj][m][0], v1 = acc[ai][bj][m][1];
                    u32x4 w; w.x = cvt_pk_bf16(v0[0] * rs[0], v0[1] * rs[1]); w.y = cvt_pk_bf16(v0[2] * rs[2], v0[3] * rs[3]); w.z = cvt_pk_bf16(v1[0] * rs[4], v1[1] * rs[5]); w.w = cvt_pk_bf16(v1[2] * rs[6], v1[3] * rs[7]);
                    *(u32x4*)(op + (size_t)(ai * HALF + m * 16) * 2048 + bj * HALF) = w;
                }
            asm volatile("" ::: "memory");
        }
    }
};

struct EpiResid {
    static constexpr bool PERM = false, AFTER_DRAIN = false, HAS_MID = false;
    const float* resid; float* out; bf16_t* hb; float* ss_out; float alpha;
    __device__ __forceinline__ void mid(f32x4 (&)[2][2][4][2], const Unit&, int, int) const {}
    __device__ __forceinline__ void operator()(const f32x4 (&acc)[2][2][4][2], const Unit& u, int wr, int wc, int fr, int fq) const {
        const int row0 = u.pm * BM + wr * 64 + fr; const int col0 = u.pn * BM + wc * 32 + 4 * fq;
        const float sc = alpha;
#pragma unroll
        for (int ai = 0; ai < 2; ++ai)
#pragma unroll
            for (int m = 0; m < 4; ++m) {
                const int row = row0 + ai * HALF + m * 16;
                const size_t off = (size_t)row * 2048 + col0;
                float s2 = 0.f;
#pragma unroll
                for (int bj = 0; bj < 2; ++bj)
#pragma unroll
                    for (int n = 0; n < 2; ++n) {
                        const f32x4 r = *(const f32x4*)(resid + off + bj * HALF + n * 16);
                        const f32x4 o = r + acc[ai][bj][m][n] * sc;
                        *(f32x4*)(out + off + bj * HALF + n * 16) = o;
                        s2 += (o[0] * o[0] + o[1] * o[1]) + (o[2] * o[2] + o[3] * o[3]);
                        if (hb) { u32x2 w; w.x = cvt_pk_bf16(o[0], o[1]); w.y = cvt_pk_bf16(o[2], o[3]); *(u32x2*)(hb + off + bj * HALF + n * 16) = w; }
                    }
                s2 += __shfl_xor(s2, 16); s2 += __shfl_xor(s2, 32);
                if (fq == 0) atomicAdd(ss_out + row, s2);
                asm volatile("" ::: "memory");
            }
    }
};
template <class Epi, class Sched, bool ALIGN_EPI = false, bool SP2 = false>
__device__ __forceinline__ void gemm_phase(PG8_LAS unsigned char* lds, const Gemm g, const Sched& S, const Epi& E) {
    int tid_ = threadIdx.x; asm volatile("" : "+v"(tid_));
    const int tid = tid_, wid = __builtin_amdgcn_readfirstlane(tid >> 6), lane = tid & 63, wr = wid >> 2, wc = wid & 3, fr = lane & 15, fq = lane >> 4;
    const int K = g.K, nt = K / BK;
    unsigned voffA[2], voffB[2];
#pragma unroll
    for (int i = 0; i < 2; ++i) { int R, C; stage_rc(tid * 16 + i * 8192, R, C); const int Rb = Epi::PERM ? ((R & ~31) + perm32(R & 31)) : R;
        voffA[i] = (unsigned)(R * K + C) * 2u; voffB[i] = (unsigned)(Rb * K + C) * 2u; }
    const size_t kstep = (size_t)(BK * 2);
    const size_t hstep = (size_t)HALF * K * 2;
    const size_t tstep = 2 * hstep;
    const unsigned ldsw = (unsigned)wid * 1024u;
    const int aoff = lds_byte(wr * 64 + fr, fq * 8), boff = lds_byte(wc * 32 + fr, fq * 8);
#define PG8_SA(b, h) (((b) * 2 + (h)) * HTB)
#define PG8_SB(b, h) ((4 + (b) * 2 + (h)) * HTB)
#define PG8_STAGE(bufoff, gbase, voff) do { _Pragma("unroll") for (int _i = 0; _i < 2; ++_i) \
        __builtin_amdgcn_global_load_lds((const unsigned*)((const char*)(gbase) + (voff)[_i]), (PG8_LAS unsigned*)(lds + (bufoff) + ldsw + _i * 8192), 16, 0, 0); } while (0)
#define PG8_LDA(dst, b, h) do { _Pragma("unroll") for (int m = 0; m < 4; ++m) _Pragma("unroll") for (int k = 0; k < 2; ++k) dst[m][k] = *(const PG8_LAS bf16x8*)(lds + PG8_SA(b, h) + aoff + m * 2048 + k * 1024); } while (0)
#define PG8_LDB(dst, b, h) do { _Pragma("unroll") for (int n = 0; n < 2; ++n) _Pragma("unroll") for (int k = 0; k < 2; ++k) dst[n][k] = *(const PG8_LAS bf16x8*)(lds + PG8_SB(b, h) + boff + n * 2048 + k * 1024); } while (0)
#define PG8_MMA(ai, bj, At, Bt) do { __builtin_amdgcn_s_setprio(1); _Pragma("unroll") for (int m = 0; m < 4; ++m) _Pragma("unroll") for (int n = 0; n < 2; ++n) _Pragma("unroll") for (int k = 0; k < 2; ++k) \
        acc[ai][bj][m][n] = __builtin_amdgcn_mfma_f32_16x16x32_bf16(Bt[n][k], At[m][k], acc[ai][bj][m][n], 0, 0, 0); __builtin_amdgcn_s_setprio(0); } while (0)
#define PG8_WAIT_V(n) asm volatile("s_waitcnt vmcnt(" #n ")" ::: "memory")
#define PG8_WAIT_L(n) asm volatile("s_waitcnt lgkmcnt(" #n ")" ::: "memory")
#define PG8_BAR __builtin_amdgcn_s_barrier()
#define PG8_SCHED __builtin_amdgcn_sched_barrier(0)
    Unit cur, nxt; int ui = 0;
    if (!S.next(0, cur)) return;
    f32x4 acc[2][2][4][2];
#pragma unroll
    for (int a = 0; a < 2; ++a)
#pragma unroll
        for (int b = 0; b < 2; ++b)
#pragma unroll
            for (int m = 0; m < 4; ++m)
#pragma unroll
                for (int n = 0; n < 2; ++n) acc[a][b][m][n] = (f32x4){0.f, 0.f, 0.f, 0.f};
    bf16x8 At[4][2], B0[2][2], B1[2][2];
    const char* cA = (const char*)g.A + (size_t)cur.pm * tstep; const char* cB = (const char*)g.Bt + (size_t)cur.pn * tstep;
    S.a_ready(cur);
    if constexpr (SP2) {
        PG8_STAGE(PG8_SB(0, 0), cB, voffB); PG8_STAGE(PG8_SB(0, 1), cB + hstep, voffB); PG8_STAGE(PG8_SA(0, 0), cA, voffA); PG8_STAGE(PG8_SA(0, 1), cA + hstep, voffA);
        if (wr == 1) PG8_BAR;
        PG8_WAIT_V(2); PG8_BAR;
        PG8_STAGE(PG8_SB(1, 0), cB + kstep, voffB); PG8_STAGE(PG8_SA(1, 0), cA + kstep, voffA); PG8_STAGE(PG8_SB(1, 1), cB + hstep + kstep, voffB);
        PG8_WAIT_V(6); PG8_BAR;
    } else {
        PG8_STAGE(PG8_SB(0, 0), cB, voffB); PG8_STAGE(PG8_SA(0, 0), cA, voffA); PG8_STAGE(PG8_SB(0, 1), cB + hstep, voffB); PG8_STAGE(PG8_SA(0, 1), cA + hstep, voffA);
        if (wr == 1) PG8_BAR;
        PG8_WAIT_V(4); PG8_BAR;
        PG8_STAGE(PG8_SB(1, 0), cB + kstep, voffB); PG8_STAGE(PG8_SA(1, 0), cA + kstep, voffA); PG8_STAGE(PG8_SB(1, 1), cB + hstep + kstep, voffB);
        PG8_WAIT_V(6); PG8_BAR;
    }
    for (;;) {
        const bool has_next = S.next(ui + 1, nxt);
        const char* nA = has_next ? (const char*)g.A + (size_t)nxt.pm * tstep : cA; const char* nB = has_next ? (const char*)g.Bt + (size_t)nxt.pn * tstep : cB;
        constexpr int NHK = Epi::HAS_MID ? 2 : 1;
#pragma unroll
        for (int hk = 0; hk < NHK; ++hk) {
        if constexpr (Epi::HAS_MID) { if (hk == 1) E.mid(acc, cur, wr, fr); }
        const int t_beg = hk * (nt / NHK), t_end = (hk + 1) * (nt / NHK);
        for (int t = t_beg; t < t_end; t += 2) {
            const bool last = (t == nt - 2);
            const char* a1 = cA + (size_t)(t + 1) * kstep;
            const char* a2 = last ? nA : cA + (size_t)(t + 2) * kstep; const char* b2 = last ? nB : cB + (size_t)(t + 2) * kstep;
            const char* a3 = a2 + kstep; const char* b3 = b2 + kstep;
            if (last && has_next) S.a_ready(nxt);
            if constexpr (SP2) {
            PG8_LDB(B0, 0, 0); PG8_LDB(B1, 0, 1); PG8_SCHED; PG8_LDA(At, 0, 0); PG8_STAGE(PG8_SA(1, 1), a1 + hstep, voffA);
            PG8_WAIT_V(8); PG8_WAIT_L(0); PG8_BAR; PG8_MMA(0, 0, At, B0); PG8_MMA(0, 1, At, B1); PG8_BAR; PG8_SCHED;
            PG8_LDA(At, 0, 1); PG8_STAGE(PG8_SB(0, 0), b2, voffB); PG8_STAGE(PG8_SB(0, 1), b2 + hstep, voffB); PG8_STAGE(PG8_SA(0, 0), a2, voffA);
            PG8_WAIT_V(8); PG8_WAIT_L(0); PG8_BAR; PG8_MMA(1, 0, At, B0); PG8_MMA(1, 1, At, B1); PG8_BAR; PG8_SCHED;
            PG8_LDB(B0, 1, 0); PG8_LDB(B1, 1, 1); PG8_SCHED; PG8_LDA(At, 1, 0); PG8_STAGE(PG8_SA(0, 1), a2 + hstep, voffA);
            PG8_WAIT_V(8); PG8_WAIT_L(0); PG8_BAR; PG8_MMA(0, 0, At, B0); PG8_MMA(0, 1, At, B1); PG8_BAR; PG8_SCHED;
            PG8_LDA(At, 1, 1); PG8_STAGE(PG8_SB(1, 0), b3, voffB); PG8_STAGE(PG8_SB(1, 1), b3 + hstep, voffB); PG8_STAGE(PG8_SA(1, 0), a3, voffA);
            PG8_WAIT_V(8); PG8_WAIT_L(0); PG8_BAR; PG8_MMA(1, 0, At, B0); PG8_MMA(1, 1, At, B1); PG8_BAR; PG8_SCHED;
            } else {
            PG8_LDB(B0, 0, 0); PG8_SCHED; PG8_LDA(At, 0, 0); PG8_STAGE(PG8_SA(1, 1), a1 + hstep, voffA);
            PG8_WAIT_L(8); PG8_BAR; PG8_WAIT_L(0); PG8_MMA(0, 0, At, B0); PG8_BAR; PG8_SCHED;
            PG8_LDB(B1, 0, 1); PG8_STAGE(PG8_SB(0, 0), b2, voffB);
            PG8_BAR; PG8_WAIT_L(0); PG8_MMA(0, 1, At, B1); PG8_BAR;
            PG8_LDA(At, 0, 1); PG8_STAGE(PG8_SA(0, 0), a2, voffA);
            PG8_BAR; PG8_WAIT_L(0); PG8_MMA(1, 0, At, B0); PG8_BAR; PG8_SCHED;
            PG8_STAGE(PG8_SB(0, 1), b2 + hstep, voffB);
            PG8_WAIT_V(6); PG8_BAR; PG8_MMA(1, 1, At, B1); PG8_BAR;
            PG8_LDB(B0, 1, 0); PG8_SCHED; PG8_LDA(At, 1, 0); PG8_STAGE(PG8_SA(0, 1), a2 + hstep, voffA);
            PG8_WAIT_L(8); PG8_BAR; PG8_WAIT_L(0); PG8_MMA(0, 0, At, B0); PG8_BAR; PG8_SCHED;
            PG8_LDB(B1, 1, 1); PG8_STAGE(PG8_SB(1, 0), b3, voffB);
            PG8_BAR; PG8_WAIT_L(0); PG8_MMA(0, 1, At, B1); PG8_BAR;
            PG8_LDA(At, 1, 1); PG8_STAGE(PG8_SA(1, 0), a3, voffA);
            PG8_BAR; PG8_WAIT_L(0); PG8_MMA(1, 0, At, B0); PG8_BAR; PG8_SCHED;
            PG8_STAGE(PG8_SB(1, 1), b3 + hstep, voffB);
            PG8_WAIT_V(6); PG8_BAR; PG8_MMA(1, 1, At, B1); PG8_BAR;
            }
        }
        }
        if constexpr (ALIGN_EPI) { if (wr == 0) PG8_BAR; }
        if constexpr (!Epi::AFTER_DRAIN) { E(acc, cur, wr, wc, fr, fq); S.done(cur); }
        if (!has_next) break;
#pragma unroll
        for (int a = 0; a < 2; ++a)
#pragma unroll
            for (int b = 0; b < 2; ++b)
#pragma unroll
                for (int m = 0; m < 4; ++m)
#pragma unroll
                    for (int n = 0; n < 2; ++n) acc[a][b][m][n] = (f32x4){0.f, 0.f, 0.f, 0.f};
        cur = nxt; cA = nA; cB = nB; ++ui;
        if constexpr (ALIGN_EPI) { if (wr == 1) PG8_BAR; }
    }
    PG8_WAIT_V(0);
    if constexpr (!ALIGN_EPI) { if (wr == 0) PG8_BAR; }
    PG8_BAR;
    if constexpr (Epi::AFTER_DRAIN) { E.fused(acc, cur, wr, wc, fr, fq, lds, wid, lane); S.done(cur); }
#undef PG8_SA
#undef PG8_SB
#undef PG8_STAGE
#undef PG8_LDA
#undef PG8_LDB
#undef PG8_MMA
#undef PG8_WAIT_V
#undef PG8_WAIT_L
#undef PG8_BAR
#undef PG8_SCHED
}
}
constexpr int NWAVES = 8;
constexpr int M = 16384, D = 2048, FF = 5632, SEQ = 2048, NB = 8, LW = 1024;
constexpr int N_PHASES = 11;
#ifndef MK_COOP
#define MK_COOP 0
#endif
constexpr size_t MiB = 1u << 20;
constexpr size_t WS_SS = 0;
constexpr size_t WS_SP8 = 6 * 65536;
constexpr size_t WS_GWP = 1 * MiB;
constexpr size_t WS_AGG = 2 * MiB;
constexpr size_t WS_W1I = 8 * MiB, WS_W1O = 52 * MiB, WS_WMI = 74 * MiB, WS_WMO = 94 * MiB, WS_W2I = 102 * MiB, WS_W2O = 146 * MiB;
constexpr size_t WS_HB = 168 * MiB;
constexpr size_t WS_Y = 232 * MiB;
constexpr size_t WS_ACT = 296 * MiB;
constexpr size_t WS_END = 472 * MiB;

#define LAS __attribute__((address_space(3)))
typedef unsigned short bf16_t;
typedef short bf16x8 __attribute__((ext_vector_type(8)));
typedef float f32x4 __attribute__((ext_vector_type(4)));
typedef unsigned u32x4 __attribute__((ext_vector_type(4)));
typedef unsigned u32x2 __attribute__((ext_vector_type(2)));
constexpr int RING_BYTES = 131072;
constexpr int LDS_BYTES = 135168;

#define LDS_WAIT() asm volatile("s_waitcnt lgkmcnt(0)" ::: "memory")
__device__ __forceinline__ unsigned pk2(float lo, float hi) { return pg8::cvt_pk_bf16(lo, hi); }
__device__ __forceinline__ float bf_lo(unsigned w) { return __uint_as_float(w << 16); }
__device__ __forceinline__ float bf_hi(unsigned w) { return __uint_as_float(w & 0xffff0000u); }
__device__ __forceinline__ float wave_sum(float v) {
#pragma unroll
    for (int o = 1; o < 64; o <<= 1) v += __shfl_xor(v, o);
    return v;
}
__device__ __forceinline__ bf16x8 mk8(float a0, float a1, float a2, float a3, float a4, float a5, float a6, float a7) {
    u32x4 w; w.x = pk2(a0, a1); w.y = pk2(a2, a3); w.z = pk2(a4, a5); w.w = pk2(a6, a7);
    return __builtin_bit_cast(bf16x8, w);
}
#define MFMA16(x, y, c) __builtin_amdgcn_mfma_f32_16x16x32_bf16((x), (y), (c), 0, 0, 0)

struct Args { const float* in[19]; float* out; unsigned char* ws; int ph_lo, ph_hi, coop, pad; };

__device__ __forceinline__ void p0_transpose_item(const float* W, int K, int N, const float* gk, bf16_t* WT, int dest_row0, LAS float* scr, int k0, int n0, int lane) {
#pragma unroll 8
    for (int i = 0; i < 32; ++i) { const int kk = 2 * i + (lane >> 5); const float g = gk ? gk[kk] : 1.0f; scr[kk * 33 + (lane & 31)] = W[(size_t)(k0 + kk) * N + n0 + (lane & 31)] * g; }
    LDS_WAIT(); asm volatile("" ::: "memory");
    const int c = lane & 7;
#pragma unroll
    for (int j = 0; j < 4; ++j) { const int n = (lane >> 3) + 8 * j; const LAS float* s = scr + (8 * c) * 33 + n;
        u32x4 o; o.x = pk2(s[0 * 33], s[1 * 33]); o.y = pk2(s[2 * 33], s[3 * 33]); o.z = pk2(s[4 * 33], s[5 * 33]); o.w = pk2(s[6 * 33], s[7 * 33]);
        *(u32x4*)(WT + (size_t)(dest_row0 + n) * K + k0 + 8 * c) = o; }
    LDS_WAIT(); asm volatile("" ::: "memory");
}
__device__ __forceinline__ int swiglu_dest(int n0) { return n0 < FF ? (n0 >> 7) * 256 + (n0 & 127) : ((n0 - FF) >> 7) * 256 + 128 + ((n0 - FF) & 127); }

__device__ __forceinline__ void p0_prologue(const Args& a, unsigned char* ws, LAS unsigned char* lds, int wave, int lane) {
    LAS float* scr = (LAS float*)(lds + wave * 16384);
    const int gw = blockIdx.x * NWAVES + wave, NGW = gridDim.x * NWAVES;
    constexpr int I_FI = (D / 64) * (2 * FF / 32), I_FO = (FF / 64) * (D / 32), I_MI = (D / 64) * (5120 / 32), I_MO = (D / 64) * (D / 32);
    constexpr int NITEMS = 2 * (I_FI + I_FO) + I_MI + I_MO;
    for (int it = gw; it < NITEMS; it += NGW) {
        int r = it;
        if (r < I_FI) { const int nblk = 2 * FF / 32, kb = r / nblk, nb = r % nblk; p0_transpose_item(a.in[2], D, 2 * FF, a.in[1] + 64 * kb, (bf16_t*)(ws + WS_W1I), swiglu_dest(32 * nb), scr, 64 * kb, 32 * nb, lane); continue; } r -= I_FI;
        if (r < I_FI) { const int nblk = 2 * FF / 32, kb = r / nblk, nb = r % nblk; p0_transpose_item(a.in[16], D, 2 * FF, a.in[15] + 64 * kb, (bf16_t*)(ws + WS_W2I), swiglu_dest(32 * nb), scr, 64 * kb, 32 * nb, lane); continue; } r -= I_FI;
        if (r < I_FO) { const int nblk = D / 32, kb = r / nblk, nb = r % nblk; p0_transpose_item(a.in[3], FF, D, nullptr, (bf16_t*)(ws + WS_W1O), 32 * nb, scr, 64 * kb, 32 * nb, lane); continue; } r -= I_FO;
        if (r < I_FO) { const int nblk = D / 32, kb = r / nblk, nb = r % nblk; p0_transpose_item(a.in[17], FF, D, nullptr, (bf16_t*)(ws + WS_W2O), 32 * nb, scr, 64 * kb, 32 * nb, lane); continue; } r -= I_FO;
        if (r < I_MI) { const int nblk = 5120 / 32, kb = r / nblk, nb = r % nblk; p0_transpose_item(a.in[5], D, 5120, a.in[4] + 64 * kb, (bf16_t*)(ws + WS_WMI), 32 * nb, scr, 64 * kb, 32 * nb, lane); continue; } r -= I_MI;
        { const int nblk = D / 32, kb = r / nblk, nb = r % nblk; const float* gk = (kb < 16) ? a.in[12] + 64 * kb : a.in[13] + 64 * (kb - 16);
          p0_transpose_item(a.in[14], D, D, gk, (bf16_t*)(ws + WS_WMO), 32 * nb, scr, 64 * kb, 32 * nb, lane); }
    }
    float* ssx = (float*)(ws + WS_SS);
    for (int m = gw; m < M; m += NGW) {
        const f32x4* xr = (const f32x4*)(a.in[0] + (size_t)m * D) + lane; f32x4 v[8]; float s = 0.f;
#pragma unroll
        for (int j = 0; j < 8; ++j) { v[j] = xr[64 * j]; s += (v[j][0] * v[j][0] + v[j][1] * v[j][1]) + (v[j][2] * v[j][2] + v[j][3] * v[j][3]); }
        s = wave_sum(s); if (lane == 0) ssx[m] = s;
        u32x2* o8 = (u32x2*)((bf16_t*)(ws + WS_HB) + (size_t)m * D) + lane;
#pragma unroll
        for (int j = 0; j < 8; ++j) { u32x2 w; w.x = pk2(v[j][0], v[j][1]); w.y = pk2(v[j][2], v[j][3]); o8[64 * j] = w; }
    }
    const int gt = blockIdx.x * (NWAVES * 64) + wave * 64 + lane, NGT = gridDim.x * NWAVES * 64;
    { float* z = (float*)(ws + WS_SS) + 16384; for (int i = gt; i < 5 * 16384; i += NGT) z[i] = 0.f; }
    { float* sp8 = (float*)(ws + WS_SP8); for (int i = gt; i < 2048; i += NGT) sp8[i] = 8.0f * log1pf(expf(-a.in[10][i])); }
    {
        const float* gw_ = a.in[8]; u32x4* gwp = (u32x4*)(ws + WS_GWP);
        for (int idx = gt; idx < 32768; idx += NGT) {
            const int ln = idx & 63, ks = (idx >> 6) & 1, jb = (idx >> 7) & 3, g = (idx >> 9) & 1, z = (idx >> 10) & 1, h = idx >> 11;
            const int fr = ln & 15, fq = ln >> 4; float v[8];
#pragma unroll
            for (int s = 0; s < 8; ++s) { const int i = 16 * (2 * ks + (s >> 2)) + 4 * fq + (s & 3), j = 16 * jb + fr; v[s] = gw_[((size_t)(((z * 2 + g) * 16 + h) * 64 + i)) * 64 + j]; }
            u32x4 w; w.x = pk2(v[0], v[1]); w.y = pk2(v[2], v[3]); w.z = pk2(v[4], v[5]); w.w = pk2(v[6], v[7]); gwp[idx] = w;
        }
    }
}

__device__ __forceinline__ float sigm(float x) { return __builtin_amdgcn_rcpf(1.0f + __expf(-x)); }
__device__ __forceinline__ float neg_expm1(float x) {
    const float p = -x * (1.0f + x * 0.5f * (1.0f + x * (1.0f / 3.0f) * (1.0f + x * 0.25f * (1.0f + x * 0.2f * (1.0f + x * (1.0f / 6.0f))))));
    return x > -0.3f ? p : 1.0f - __expf(x);
}
struct LruCtx { const bf16_t* xl; const bf16_t* gl; const float* convw; const float* convb; const u32x4* gwp; const float* gateb; const float* sp8; float* aggA; float* aggB; bf16_t* y; float* ssA; };

template <int PASS, int DIR>
__device__ __forceinline__ void lru_sweep(const LruCtx& C, int b, int h, int chunk, int lane, float (&carry)[4][4], float (&atot)[4][4], LAS float* hfl) {
    const int fr = lane & 15, fq = lane >> 4;
    const int last_lane = (lane & 48) | (DIR == 0 ? 15 : 0);
    const float* convw = C.convw; const float* convb = C.convb; const float* gateb = C.gateb; const float* sp8 = C.sp8; const u32x4* gwp = C.gwp;
#pragma unroll 1
    for (int t = 0; t < 4; ++t) {
        asm volatile("" : "+s"(convw), "+s"(convb), "+s"(gateb), "+s"(sp8), "+s"(gwp));
        const int tbi = DIR == 0 ? t : 3 - t;
        const int s_tok = chunk * 64 + tbi * 16 + fr;
        float xc[4][4];
#pragma unroll
        for (int jb = 0; jb < 4; ++jb) {
            const int ch = h * 64 + 16 * jb + 4 * fq;
            f32x4 av = *(const f32x4*)(convb + ch);
#pragma unroll
            for (int tap = 0; tap < 4; ++tap) {
                const int s = s_tok + tap - 2; const bool ok = (s >= 0) && (s < SEQ); const int sc = ok ? s : s_tok;
                const u32x2 raw = *(const u32x2*)(C.xl + ((size_t)(b * SEQ + sc)) * LW + ch);
                const f32x4 w = *(const f32x4*)(convw + tap * LW + ch);
                f32x4 xv = (f32x4){bf_lo(raw.x), bf_hi(raw.x), bf_lo(raw.y), bf_hi(raw.y)};
                if (!ok) xv = (f32x4){0.f, 0.f, 0.f, 0.f};
                av = av + w * xv;
            }
#pragma unroll
            for (int e = 0; e < 4; ++e) xc[jb][e] = av[e];
        }
        const bf16x8 xb0 = mk8(xc[0][0], xc[0][1], xc[0][2], xc[0][3], xc[1][0], xc[1][1], xc[1][2], xc[1][3]);
        const bf16x8 xb1 = mk8(xc[2][0], xc[2][1], xc[2][2], xc[2][3], xc[3][0], xc[3][1], xc[3][2], xc[3][3]);
        float ssq = 0.f;
#pragma unroll
        for (int jb = 0; jb < 4; ++jb) {
            const int ch = h * 64 + 16 * jb + 4 * fq;
            const u32x4* wr_ = gwp + ((size_t)((((h * 2 + DIR) * 2 + 0) * 4 + jb) * 2)) * 64 + lane;
            const u32x4* wi_ = gwp + ((size_t)((((h * 2 + DIR) * 2 + 1) * 4 + jb) * 2)) * 64 + lane;
            f32x4 ar = (f32x4){0.f, 0.f, 0.f, 0.f}, ai = (f32x4){0.f, 0.f, 0.f, 0.f};
            ar = MFMA16(__builtin_bit_cast(bf16x8, wr_[0]), xb0, ar); ar = MFMA16(__builtin_bit_cast(bf16x8, wr_[64]), xb1, ar);
            ai = MFMA16(__builtin_bit_cast(bf16x8, wi_[0]), xb0, ai); ai = MFMA16(__builtin_bit_cast(bf16x8, wi_[64]), xb1, ai);
            const f32x4 br = *(const f32x4*)(gateb + ((DIR * 2 + 0) * 16 + h) * 64 + 16 * jb + 4 * fq);
            const f32x4 bi = *(const f32x4*)(gateb + ((DIR * 2 + 1) * 16 + h) * 64 + 16 * jb + 4 * fq);
            const f32x4 sp = *(const f32x4*)(sp8 + DIR * LW + ch);
            f32x4 gv = (f32x4){0.f, 0.f, 0.f, 0.f};
            if (PASS == 2 && DIR == 1) { const u32x2 raw = *(const u32x2*)(C.gl + ((size_t)(b * SEQ + s_tok)) * LW + ch); gv = (f32x4){bf_lo(raw.x), bf_hi(raw.x), bf_lo(raw.y), bf_hi(raw.y)}; }
            float yo[4];
#pragma unroll
            for (int e = 0; e < 4; ++e) {
                const float rg = sigm(ar[e] + br[e]), ig = sigm(ai[e] + bi[e]);
                const float la = -rg * sp[e];
                float av = __expf(la);
                float bv = sqrtf(neg_expm1(2.0f * la)) * (ig * xc[jb][e]);
#pragma unroll
                for (int d = 1; d < 16; d <<= 1) {
                    float ap, bp; bool ok;
                    if (DIR == 0) { ap = __shfl_up(av, d, 16); bp = __shfl_up(bv, d, 16); ok = fr >= d; }
                    else { ap = __shfl_down(av, d, 16); bp = __shfl_down(bv, d, 16); ok = fr + d < 16; }
                    if (ok) { bv = av * bp + bv; av = av * ap; }
                }
                const float hv = bv + av * carry[jb][e];
                carry[jb][e] = __shfl(hv, last_lane);
                if (PASS == 1) atot[jb][e] = atot[jb][e] * __shfl(av, last_lane);
                if (PASS == 2 && DIR == 0) hfl[(tbi * 16 + jb * 4 + e) * 64 + lane] = hv;
                if (PASS == 2 && DIR == 1) {
                    const float hfv = hfl[(tbi * 16 + jb * 4 + e) * 64 + lane];
                    const float g = gv[e]; const float ge = g * sigm(1.5957691216f * (g + 0.044715f * g * g * g));
                    const float yv = ge * (hfv + hv); yo[e] = yv; ssq += yv * yv;
                }
            }
            if (PASS == 2 && DIR == 1) { u32x2 w; w.x = pk2(yo[0], yo[1]); w.y = pk2(yo[2], yo[3]); *(u32x2*)(C.y + ((size_t)(b * SEQ + s_tok)) * D + ch) = w; }
        }
        if (PASS == 2 && DIR == 1) { ssq += __shfl_xor(ssq, 16); ssq += __shfl_xor(ssq, 32); if (fq == 0) atomicAdd(C.ssA + b * SEQ + s_tok, ssq); }
    }
}

template <int PASS, int DIR>
__device__ __forceinline__ void lru_dir(const LruCtx& C, int b, int h, int chunk, int lane, LAS float* hfl) {
    const int fr = lane & 15, fq = lane >> 4;
    float carry[4][4], atot[4][4];
#pragma unroll
    for (int jb = 0; jb < 4; ++jb)
#pragma unroll
        for (int e = 0; e < 4; ++e) { carry[jb][e] = 0.f; atot[jb][e] = 1.f; }
    if (PASS == 2) {
        const int n = DIR == 0 ? chunk : 31 - chunk;
#pragma unroll 1
        for (int i = 0; i < n; ++i) {
            const int cc = DIR == 0 ? i : 31 - i;
            const size_t o = ((size_t)((DIR * NB + b) * 32 + cc)) * LW + h * 64 + 4 * fq;
#pragma unroll
            for (int jb = 0; jb < 4; ++jb) { const f32x4 A = *(const f32x4*)(C.aggA + o + 16 * jb), Bv = *(const f32x4*)(C.aggB + o + 16 * jb);
#pragma unroll
                for (int e = 0; e < 4; ++e) carry[jb][e] = A[e] * carry[jb][e] + Bv[e]; }
        }
    }
    lru_sweep<PASS, DIR>(C, b, h, chunk, lane, carry, atot, hfl);
    if (PASS == 1 && fr == 0) {
        const size_t o = ((size_t)((DIR * NB + b) * 32 + chunk)) * LW + h * 64 + 4 * fq;
#pragma unroll
        for (int jb = 0; jb < 4; ++jb) { *(f32x4*)(C.aggA + o + 16 * jb) = (f32x4){atot[jb][0], atot[jb][1], atot[jb][2], atot[jb][3]}; *(f32x4*)(C.aggB + o + 16 * jb) = (f32x4){carry[jb][0], carry[jb][1], carry[jb][2], carry[jb][3]}; }
    }
}
template <int PASS>
__device__ __forceinline__ void lru_unit(const LruCtx& C, int unit, int lane, LAS unsigned char* wl) {
    const int chunk = unit & 31, h = (unit >> 5) & 15, b = unit >> 9;
    LAS float* hfl = (LAS float*)wl;
    lru_dir<PASS, 0>(C, b, h, chunk, lane, hfl);
    lru_dir<PASS, 1>(C, b, h, chunk, lane, hfl);
}

struct AttnCtx { const bf16_t* q; const bf16_t* k; const bf16_t* vT; const float* rpb; bf16_t* y; float* ssB; };
__device__ __forceinline__ void attn_unit(const AttnCtx& C, int unit, int lane) {
    const int j = unit & 3, h = (unit >> 2) & 15, r = (unit >> 6) & 31, b = unit >> 11;
    const int fr = lane & 15, fq = lane >> 4;
    const int rs = min(max(r - 4, 0), 24), kc0 = min(max(16 * j - 8, 0), 32);
    const int qcol = 16 * j + fr, cs = min(max(qcol - 8, 0), 48);
    const size_t tq = (size_t)b * SEQ + r * 64 + qcol;
    const bf16x8 q0 = *(const bf16x8*)(C.q + tq * LW + h * 64 + 8 * fq), q1 = *(const bf16x8*)(C.q + tq * LW + h * 64 + 32 + 8 * fq);
    float sv[8][8];
    float mx = -INFINITY;
#pragma unroll
    for (int rr = 0; rr < 8; ++rr) {
        const float* bias_row = C.rpb + (h * 15 + (rs + rr - r + 7)) * 31;
#pragma unroll
        for (int p = 0; p < 2; ++p) {
            const int cc = 8 * (fr >> 2) + 4 * p + (fr & 3);
            const size_t tk = (size_t)b * SEQ + (rs + rr) * 64 + kc0 + cc;
            const bf16x8 k0 = *(const bf16x8*)(C.k + tk * LW + h * 64 + 8 * fq), k1 = *(const bf16x8*)(C.k + tk * LW + h * 64 + 32 + 8 * fq);
            f32x4 acc = (f32x4){0.f, 0.f, 0.f, 0.f};
            acc = MFMA16(k0, q0, acc); acc = MFMA16(k1, q1, acc);
#pragma unroll
            for (int e = 0; e < 4; ++e) {
                const int kcol = kc0 + 8 * fq + 4 * p + e;
                const bool valid = (kcol >= cs) && (kcol < cs + 16);
                const int bi = min(max(kcol - qcol + 15, 0), 30);
                const float v = valid ? acc[e] + bias_row[bi] : -INFINITY;
                sv[rr][4 * p + e] = v; mx = fmaxf(mx, v);
            }
        }
    }
    mx = fmaxf(mx, __shfl_xor(mx, 16)); mx = fmaxf(mx, __shfl_xor(mx, 32));
    float sum = 0.f;
#pragma unroll
    for (int rr = 0; rr < 8; ++rr)
#pragma unroll
        for (int i = 0; i < 8; ++i) { const float p = __expf(sv[rr][i] - mx); sv[rr][i] = p; sum += p; }
    sum += __shfl_xor(sum, 16); sum += __shfl_xor(sum, 32);
    f32x4 o[4];
#pragma unroll
    for (int d = 0; d < 4; ++d) o[d] = (f32x4){0.f, 0.f, 0.f, 0.f};
#pragma unroll
    for (int rr = 0; rr < 8; ++rr) {
        const bf16x8 pf = mk8(sv[rr][0], sv[rr][1], sv[rr][2], sv[rr][3], sv[rr][4], sv[rr][5], sv[rr][6], sv[rr][7]);
#pragma unroll
        for (int d = 0; d < 4; ++d) {
            const bf16x8 vf = *(const bf16x8*)(C.vT + ((size_t)((b * 16 + h) * 64 + 16 * d + fr)) * SEQ + (rs + rr) * 64 + kc0 + 8 * fq);
            o[d] = MFMA16(vf, pf, o[d]);
        }
    }
    const float inv = 1.0f / sum; float ssq = 0.f;
#pragma unroll
    for (int d = 0; d < 4; ++d) {
        const f32x4 ov = o[d] * inv; ssq += (ov[0] * ov[0] + ov[1] * ov[1]) + (ov[2] * ov[2] + ov[3] * ov[3]);
        u32x2 w; w.x = pk2(ov[0], ov[1]); w.y = pk2(ov[2], ov[3]);
        *(u32x2*)(C.y + tq * D + LW + h * 64 + 16 * d + 4 * fq) = w;
    }
    ssq += __shfl_xor(ssq, 16); ssq += __shfl_xor(ssq, 32);
    if (fq == 0) atomicAdd(C.ssB + tq, ssq);
}

__global__ void __launch_bounds__(NWAVES * 64, 2) mk_fwd(Args args) {
    extern __shared__ __attribute__((aligned(16))) unsigned char lds_raw[];
    LAS unsigned char* lds = (LAS unsigned char*)lds_raw;
    for (int ph = args.ph_lo; ph < args.ph_hi; ++ph) {
        int tid = threadIdx.x; asm volatile("" : "+v"(tid));
        unsigned char* ws = args.ws; asm volatile("" : "+s"(ws));
        const int lane = tid & 63, wave = __builtin_amdgcn_readfirstlane(tid >> 6);
        float* SS = (float*)(ws + WS_SS);
        float *ssx = SS, *ssh1 = SS + 16384, *ssA = SS + 2 * 16384, *ssB = SS + 3 * 16384, *ssh2 = SS + 4 * 16384, *ssh3 = SS + 5 * 16384;
        bf16_t* HB = (bf16_t*)(ws + WS_HB); bf16_t* Y = (bf16_t*)(ws + WS_Y); bf16_t* ACT = (bf16_t*)(ws + WS_ACT);
        const int G = gridDim.x, gw = blockIdx.x * NWAVES + wave, NGW = G * NWAVES;
        if (ph == 0) {
#ifndef NO_P0
            p0_prologue(args, ws, lds, wave, lane);
#endif
        } else if (ph == 1 || ph == 8) {
            const bool f1 = (ph == 1);
            pg8::Gemm g{HB, (const bf16_t*)(ws + (f1 ? WS_W1I : WS_W2I)), M, 2 * FF, D}; pg8::StaticOrder S; S.init(M, 2 * FF, G, (int)blockIdx.x);
            pg8::EpiSwiGLU E{f1 ? ssx : ssh2, ACT, FF};
#if !defined(NO_GEMM) && !defined(NO_G1)
            pg8::gemm_phase<pg8::EpiSwiGLU, pg8::StaticOrder, true, true>(lds, g, S, E);
#endif
        } else if (ph == 2 || ph == 7 || ph == 9) {
            const bf16_t* A = (ph == 7) ? Y : ACT; const int K = (ph == 7) ? D : FF;
            const bf16_t* Bt = (const bf16_t*)(ws + (ph == 2 ? WS_W1O : (ph == 7 ? WS_WMO : WS_W2O)));
            pg8::Gemm g{A, Bt, M, D, K}; pg8::StaticOrder S; S.init(M, D, G, (int)blockIdx.x);
            pg8::EpiResid E{ph == 2 ? args.in[0] : args.out, args.out, ph == 9 ? (bf16_t*)nullptr : HB, ph == 2 ? ssh1 : (ph == 7 ? ssh2 : ssh3), ph == 7 ? 1.0f : 0.5f};
#if !defined(NO_GEMM) && !defined(NO_G2)
            pg8::gemm_phase<pg8::EpiResid, pg8::StaticOrder, true, true>(lds, g, S, E);
#endif
        } else if (ph == 3) {
            { pg8::Gemm g{HB, (const bf16_t*)(ws + WS_WMI), M, 4096, D}; pg8::StaticOrder S; S.init(M, 4096, G, (int)blockIdx.x);
              pg8::EpiProj E{ssh1, ACT};
#if !defined(NO_GEMM) && !defined(NO_G3)
              pg8::gemm_phase<pg8::EpiProj, pg8::StaticOrder, true, true>(lds, g, S, E);
#endif
            }
            { pg8::Gemm g{(const bf16_t*)(ws + WS_WMI) + (size_t)4096 * D, HB, 1024, M, D}; pg8::StaticOrder S; S.init(1024, M, G, (int)blockIdx.x);
              pg8::EpiVT E{ssh1, ACT + 4 * (size_t)M * LW};
#if !defined(NO_GEMM) && !defined(NO_G4)
              pg8::gemm_phase<pg8::EpiVT, pg8::StaticOrder, true, true>(lds, g, S, E);
#endif
            }
        } else if (ph == 4 || ph == 5) {
            const size_t SEG = (size_t)M * LW;
            LruCtx C{ACT, ACT + SEG, args.in[6], args.in[7], (const u32x4*)(ws + WS_GWP), args.in[9], (const float*)(ws + WS_SP8), (float*)(ws + WS_AGG), (float*)(ws + WS_AGG + 2 * MiB), Y, ssA};
            if (ph == 4) {
#ifndef NO_LRU1
                for (int u = gw; u < 4096; u += NGW) lru_unit<1>(C, u, lane, lds + wave * 16384);
#endif
                AttnCtx A{ACT + 2 * SEG, ACT + 3 * SEG, ACT + 4 * SEG, args.in[11], Y, ssB};
#ifndef NO_ATTN
                for (int u = gw; u < 16384; u += NGW) attn_unit(A, u, lane);
#endif
            } else {
#ifndef NO_LRU2
                for (int u = gw; u < 4096; u += NGW) lru_unit<2>(C, u, lane, lds + wave * 16384);
#endif
            }
        } else if (ph == 6) {
            for (int m = gw; m < M; m += NGW) {
                const float ra = pg8::rstd_of(ssA[m], 1.0f / 1024.0f), rb = pg8::rstd_of(ssB[m], 1.0f / 1024.0f);
                u32x4* yr = (u32x4*)(Y + (size_t)m * D) + lane;
#pragma unroll
                for (int j = 0; j < 4; ++j) { const float r = j < 2 ? ra : rb; u32x4 w = yr[64 * j];
                    w.x = pk2(bf_lo(w.x) * r, bf_hi(w.x) * r); w.y = pk2(bf_lo(w.y) * r, bf_hi(w.y) * r); w.z = pk2(bf_lo(w.z) * r, bf_hi(w.z) * r); w.w = pk2(bf_lo(w.w) * r, bf_hi(w.w) * r); yr[64 * j] = w; }
            }
        } else {
            const float* gF = args.in[18];
            for (int m = gw; m < M; m += NGW) {
                f32x4* orow = (f32x4*)(args.out + (size_t)m * D) + lane; const f32x4* gr = (const f32x4*)gF + lane;
                const float rs = pg8::rstd_of(ssh3[m], 1.0f / 2048.0f);
#pragma unroll
                for (int j = 0; j < 8; ++j) { const f32x4 v = orow[64 * j], g = gr[64 * j]; orow[64 * j] = v * g * rs; }
            }
        }
        if (ph + 1 < args.ph_hi) { if (args.coop) cg::this_grid().sync(); }
    }
}

extern "C" void kernel_launch(void* const* d_in, const int* in_sizes, int n_in, void* d_out, int out_size, void* d_ws, size_t ws_size, hipStream_t stream) {
    static int grid = 0;
    if (grid == 0) {
        if (n_in != 19 || out_size != M * D || ws_size < WS_END) { fprintf(stderr, "kernel_launch: unexpected shapes (n_in %d, out %d, ws %zu)\n", n_in, out_size, ws_size); grid = -1; return; }
        int dev = 0, cus = 0, per_cu = 0;
        hipGetDevice(&dev); hipDeviceGetAttribute(&cus, hipDeviceAttributeMultiprocessorCount, dev);
        if (hipFuncSetAttribute((const void*)mk_fwd, hipFuncAttributeMaxDynamicSharedMemorySize, LDS_BYTES) != hipSuccess) { fprintf(stderr, "kernel_launch: hipFuncSetAttribute failed\n"); grid = -1; return; }
        if (hipOccupancyMaxActiveBlocksPerMultiprocessor(&per_cu, (const void*)mk_fwd, NWAVES * 64, LDS_BYTES) != hipSuccess || per_cu < 1) { fprintf(stderr, "kernel_launch: occupancy query says %d\n", per_cu); per_cu = 1; }
        (void)hipGetLastError();
        grid = cus * 1;
        if (grid != 256) fprintf(stderr, "kernel_launch: note: grid %d\n", grid);
    }
    if (grid < 0) return;
    Args a{};
    for (int i = 0; i < 19; ++i) a.in[i] = (const float*)d_in[i];
    a.out = (float*)d_out; a.ws = (unsigned char*)d_ws;
#if MK_COOP
    a.ph_lo = 0; a.ph_hi = N_PHASES; a.coop = 1;
    void* kargs[] = {&a};
    hipError_t e = hipLaunchCooperativeKernel((const void*)mk_fwd, dim3(grid), dim3(NWAVES * 64), kargs, LDS_BYTES, stream);
    if (e != hipSuccess) fprintf(stderr, "kernel_launch: cooperative launch failed: %s\n", hipGetErrorString(e));
#else
    for (int ph = 0; ph < N_PHASES; ++ph) {
        a.ph_lo = ph; a.ph_hi = ph + 1; a.coop = 0;
        hipLaunchKernelGGL(mk_fwd, dim3(grid), dim3(NWAVES * 64), LDS_BYTES, stream, a);
    }
#endif
}
```

```cpp
#include <hip/hip_runtime.h>
#include <hip/hip_cooperative_groups.h>
#include <cstdio>
#include <cstdint>
#include <cmath>
namespace cg = cooperative_groups;
namespace pg8 {
#define PG8_LAS __attribute__((address_space(3)))
typedef unsigned short bf16_t;
typedef short bf16x8 __attribute__((ext_vector_type(8)));
typedef float f32x4 __attribute__((ext_vector_type(4)));
typedef unsigned u32x4 __attribute__((ext_vector_type(4)));
constexpr int BM = 256, BK = 64, HALF = 128, HTB = HALF * BK * 2  , STAGE_BYTES = 8 * HTB, NXCD = 8, WGM = 8;

__host__ __device__ __forceinline__ int lds_byte(int r, int c) { const int st = (r >> 4) * 2 + (c >> 5), rr = r & 15, cc = c & 31, ob = rr * 64 + cc * 2; return st * 1024 + (ob ^ (((ob >> 9) & 1) << 5)); }
__host__ __device__ __forceinline__ void stage_rc(int b, int& R, int& C) { const int st = b / 1024, sb = b % 1024, swz = sb ^ (((sb >> 9) & 1) << 5); R = (st >> 1) * 16 + swz / 64; C = (st & 1) * 32 + (swz % 64) / 2; }
__host__ __device__ __forceinline__ int perm32(int rho) { const int n = rho >> 4, i = rho & 15; return 8 * (i >> 2) + 4 * n + (i & 3); }

struct Unit { int pm, pn; };
struct Gemm { const bf16_t* A; const bf16_t* Bt; int M, N, K; };

struct StaticOrder {
    int nM, nN, nwg, G, c;
    __host__ __device__ void init(int M, int N, int G_, int c_) { nM = M / BM; nN = N / BM; nwg = nM * nN; G = G_; c = c_; }
    __host__ __device__ bool next(int i, Unit& u) const {
        const long L = (long)i * G + c; if (L >= nwg) return false;
        int wgid = (int)L; { const int q = nwg / NXCD, r = nwg % NXCD, xcd = wgid % NXCD, off = wgid / NXCD; wgid = (xcd < r ? xcd * (q + 1) : r * (q + 1) + (xcd - r) * q) + off; }
        const int nig = WGM * nN, gid = wgid / nig, fm = gid * WGM, gsz = (nM - fm) < WGM ? (nM - fm) : WGM;
        u.pm = fm + ((wgid % nig) % gsz); u.pn = (wgid % nig) / gsz; return true;
    }
    __device__ __forceinline__ void a_ready(const Unit&) const {}
    __device__ __forceinline__ void done(const Unit&) const {}
};

__device__ __forceinline__ unsigned cvt_pk_bf16(float lo, float hi) { unsigned r; asm volatile("v_cvt_pk_bf16_f32 %0, %1, %2" : "=v"(r) : "v"(lo), "v"(hi)); return r; }
typedef float f32x2 __attribute__((ext_vector_type(2)));
#define GAS __attribute__((address_space(1)))
template <class T> __device__ __forceinline__ T gld(const void* p) { return *(const GAS T*)p; }
template <class T> __device__ __forceinline__ void gst(void* p, T v) { *(GAS T*)p = v; }
template <class T> __device__ __forceinline__ void gst_nt(void* p, T v) { __builtin_nontemporal_store(v, (GAS T*)p); }
template <class T> __device__ __forceinline__ T gld_nt(const void* p) { return __builtin_nontemporal_load((const GAS T*)p); }
__device__ __forceinline__ void gatomic_add(float* p, float v) { (void)__hip_atomic_fetch_add((GAS float*)p, v, __ATOMIC_RELAXED, __HIP_MEMORY_SCOPE_AGENT); }
typedef unsigned u32x2 __attribute__((ext_vector_type(2)));
constexpr float RMS_EPS = 1e-6f;
__device__ __forceinline__ float rstd_of(float ss, float inv_n) { return __builtin_amdgcn_rsqf(ss * inv_n + RMS_EPS); }
__device__ __forceinline__ float silu_f(float g) { return g * __builtin_amdgcn_rcpf(1.0f + __expf(-g)); }

struct EpiSwiGLU {
    static constexpr bool PERM = true, AFTER_DRAIN = false, HAS_MID = false;
    const float* ss; bf16_t* O; int ldo;
    __device__ __forceinline__ void mid(f32x4 (&)[2][2][4][2], const Unit&, int, int) const {}
    __device__ __forceinline__ void operator()(const f32x4 (&acc)[2][2][4][2], const Unit& u, int wr, int wc, int fr, int fq) const {
        const int row0 = u.pm * BM + wr * 64 + fr; const int col0 = u.pn * HALF + wc * 32 + 8 * fq;
        float rsv[2][4];
#pragma unroll
        for (int ai = 0; ai < 2; ++ai)
#pragma unroll
            for (int m = 0; m < 4; ++m) rsv[ai][m] = gld<float>(ss + row0 + ai * HALF + m * 16);
        __builtin_amdgcn_sched_barrier(0);
#pragma unroll
        for (int ai = 0; ai < 2; ++ai)
#pragma unroll
            for (int m = 0; m < 4; ++m) {
                const int row = row0 + ai * HALF + m * 16;
                const float rs = rstd_of(rsv[ai][m], 1.0f / 2048.0f);
                float v[8];
                const float cneg = rs * -1.44269504089f, rs2 = rs * rs;
#pragma unroll
                for (int n = 0; n < 2; ++n)
#pragma unroll
                    for (int hh = 0; hh < 2; ++hh) {
                        const f32x2 g = (f32x2){acc[ai][0][m][n][2 * hh], acc[ai][0][m][n][2 * hh + 1]}, up = (f32x2){acc[ai][1][m][n][2 * hh], acc[ai][1][m][n][2 * hh + 1]};
                        const f32x2 t = g * cneg;
                        f32x2 d; d.x = __builtin_amdgcn_exp2f(t.x); d.y = __builtin_amdgcn_exp2f(t.y); d = d + 1.0f;
                        f32x2 r; r.x = __builtin_amdgcn_rcpf(d.x); r.y = __builtin_amdgcn_rcpf(d.y);
                        const f32x2 o = (g * up) * (r * rs2);
                        v[n * 4 + 2 * hh] = o.x; v[n * 4 + 2 * hh + 1] = o.y;
                    }
                u32x4 w; w.x = cvt_pk_bf16(v[0], v[1]); w.y = cvt_pk_bf16(v[2], v[3]); w.z = cvt_pk_bf16(v[4], v[5]); w.w = cvt_pk_bf16(v[6], v[7]);
                gst<u32x4>(O + (size_t)row * ldo + col0, w);
            }
    }
};

struct EpiProj {
    static constexpr bool PERM = true, AFTER_DRAIN = false, HAS_MID = false;
    const float* ss; bf16_t* base;
    __device__ __forceinline__ void mid(f32x4 (&)[2][2][4][2], const Unit&, int, int) const {}
    __device__ __forceinline__ void operator()(const f32x4 (&acc)[2][2][4][2], const Unit& u, int wr, int wc, int fr, int fq) const {
        const int seg = u.pn >> 2; const int colt = (u.pn & 3) * BM + wc * 32 + 8 * fq;
        const int row0 = u.pm * BM + wr * 64 + fr;
        const float qs = (seg == 2) ? 0.125f : 1.0f;
        bf16_t* op = base + (size_t)seg * ((size_t)16384 * 1024) + (size_t)row0 * 1024 + colt;
        float rsv[2][4];
#pragma unroll
        for (int ai = 0; ai < 2; ++ai)
#pragma unroll
            for (int m = 0; m < 4; ++m) rsv[ai][m] = gld<float>(ss + row0 + ai * HALF + m * 16);
        __builtin_amdgcn_sched_barrier(0);
        const int kb_b = (u.pm * BM) >> 11, kb_s0 = row0 & 2047;
#pragma unroll
        for (int ai = 0; ai < 2; ++ai)
#pragma unroll
            for (int m = 0; m < 4; ++m) {
                const float rs = rstd_of(rsv[ai][m], 1.0f / 2048.0f) * qs;
#pragma unroll
                for (int bj = 0; bj < 2; ++bj) {
                    const f32x4 v0 = acc[ai][bj][m][0] * rs, v1 = acc[ai][bj][m][1] * rs;
                    u32x4 w; w.x = cvt_pk_bf16(v0[0], v0[1]); w.y = cvt_pk_bf16(v0[2], v0[3]); w.z = cvt_pk_bf16(v1[0], v1[1]); w.w = cvt_pk_bf16(v1[2], v1[3]);
                    if (seg == 3) { const int col = colt + bj * HALF, s = kb_s0 + ai * HALF + m * 16;
                        gst<u32x4>(base + (size_t)3 * ((size_t)16384 * 1024) + ((((size_t)(kb_b * 16 + (col >> 6))) * 2 + ((col >> 5) & 1)) * 2048 + s) * 32 + (col & 31), w); }
                    else gst<u32x4>(op + (size_t)(ai * HALF + m * 16) * 1024 + bj * HALF, w);
                }
                asm volatile("" ::: "memory");
            }
    }
};
struct EpiVT {
    static constexpr bool PERM = true, AFTER_DRAIN = false, HAS_MID = false;
    const float* ss; bf16_t* vT;
    __device__ __forceinline__ void mid(f32x4 (&)[2][2][4][2], const Unit&, int, int) const {}
    __device__ __forceinline__ void operator()(const f32x4 (&acc)[2][2][4][2], const Unit& u, int wr, int wc, int fr, int fq) const {
        const int tok0 = u.pn * BM + wc * 32 + 8 * fq;
        const int b = tok0 >> 11, s0 = tok0 & 2047;
#pragma unroll
        for (int bj = 0; bj < 2; ++bj) {
            const f32x4 s_lo = gld<f32x4>(ss + tok0 + bj * HALF), s_hi = gld<f32x4>(ss + tok0 + bj * HALF + 4);
            float rs[8];
#pragma unroll
            for (int e = 0; e < 4; ++e) { rs[e] = rstd_of(s_lo[e], 1.0f / 2048.0f); rs[4 + e] = rstd_of(s_hi[e], 1.0f / 2048.0f); }
#pragma unroll
            for (int ai = 0; ai < 2; ++ai)
#pragma unroll
                for (int m = 0; m < 4; ++m) {
                    const f32x4 v0 = acc[ai][bj][m][0], v1 = acc[ai][bj][m][1];
                    u32x4 w; w.x = cvt_pk_bf16(v0[0] * rs[0], v0[1] * rs[1]); w.y = cvt_pk_bf16(v0[2] * rs[2], v0[3] * rs[3]); w.z = cvt_pk_bf16(v1[0] * rs[4], v1[1] * rs[5]); w.w = cvt_pk_bf16(v1[2] * rs[6], v1[3] * rs[7]);
                    { const int hh = 4 * u.pm + wr + 2 * ai, dd = 16 * m + fr, s = s0 + bj * HALF;
                      gst<u32x4>(vT + ((((size_t)((b * 16 + hh) * 32 + (s >> 6))) * 8 + ((s >> 3) & 7)) * 64 + dd) * 8, w); }
                }
            asm volatile("" ::: "memory");
        }
    }
};

template <bool MIX> struct EpiResid {
    static constexpr bool PERM = true, AFTER_DRAIN = false, HAS_MID = MIX;
    const float* resid_f; bf16_t* hb; float* ss_out; float alpha; const float* ssA; const float* ssB;
    __device__ __forceinline__ void mid(f32x4 (&acc)[2][2][4][2], const Unit& u, int wr, int fr) const {
        if constexpr (MIX) {
            const int row0 = u.pm * BM + wr * 64 + fr;
            float sa[2][4], sb[2][4];
#pragma unroll
            for (int ai = 0; ai < 2; ++ai)
#pragma unroll
                for (int m = 0; m < 4; ++m) { sa[ai][m] = gld<float>(ssA + row0 + ai * HALF + m * 16); sb[ai][m] = gld<float>(ssB + row0 + ai * HALF + m * 16); }
#pragma unroll
            for (int ai = 0; ai < 2; ++ai)
#pragma unroll
                for (int m = 0; m < 4; ++m) {
                    const float f = rstd_of(sa[ai][m], 1.0f / 1024.0f) * __builtin_amdgcn_rcpf(rstd_of(sb[ai][m], 1.0f / 1024.0f));
#pragma unroll
                    for (int bj = 0; bj < 2; ++bj)
#pragma unroll
                        for (int n = 0; n < 2; ++n) acc[ai][bj][m][n] = acc[ai][bj][m][n] * f;
                }
        }
    }
    __device__ __forceinline__ void operator()(const f32x4 (&acc)[2][2][4][2], const Unit& u, int wr, int wc, int fr, int fq) const {
        const int row0 = u.pm * BM + wr * 64 + fr; const int col0 = u.pn * BM + wc * 32 + 8 * fq;
#pragma unroll
        for (int ai = 0; ai < 2; ++ai) {
            float sbv[4] = {0.f, 0.f, 0.f, 0.f};
            if constexpr (MIX) {
#pragma unroll
                for (int m = 0; m < 4; ++m) sbv[m] = gld<float>(ssB + row0 + ai * HALF + m * 16);
            }
            f32x4 pre[4][2][2];
            if (resid_f) {
#pragma unroll
                for (int m = 0; m < 4; ++m) { const size_t off = (size_t)(row0 + ai * HALF + m * 16) * 2048 + col0;
#pragma unroll
                    for (int bj = 0; bj < 2; ++bj)
#pragma unroll
                        for (int n = 0; n < 2; ++n) pre[m][bj][n] = gld_nt<f32x4>(resid_f + off + bj * HALF + n * 4); }
            } else {
                u32x4 raw[4][2];
#pragma unroll
                for (int m = 0; m < 4; ++m) { const size_t off = (size_t)(row0 + ai * HALF + m * 16) * 2048 + col0;
#pragma unroll
                    for (int bj = 0; bj < 2; ++bj) raw[m][bj] = gld<u32x4>(hb + off + bj * HALF); }
                __builtin_amdgcn_sched_barrier(0);
#pragma unroll
                for (int m = 0; m < 4; ++m)
#pragma unroll
                    for (int bj = 0; bj < 2; ++bj) { const u32x4 r = raw[m][bj];
                        pre[m][bj][0] = (f32x4){__uint_as_float(r.x << 16), __uint_as_float(r.x & 0xffff0000u), __uint_as_float(r.y << 16), __uint_as_float(r.y & 0xffff0000u)};
                        pre[m][bj][1] = (f32x4){__uint_as_float(r.z << 16), __uint_as_float(r.z & 0xffff0000u), __uint_as_float(r.w << 16), __uint_as_float(r.w & 0xffff0000u)}; }
            }
            __builtin_amdgcn_sched_barrier(0);
#pragma unroll
            for (int m = 0; m < 4; ++m) {
                const int row = row0 + ai * HALF + m * 16;
                const size_t off = (size_t)row * 2048 + col0;
                float s2 = 0.f;
                const float sc = MIX ? rstd_of(sbv[m], 1.0f / 1024.0f) : alpha;
#pragma unroll
                for (int bj = 0; bj < 2; ++bj) {
                    const f32x4 o0 = pre[m][bj][0] + acc[ai][bj][m][0] * sc, o1 = pre[m][bj][1] + acc[ai][bj][m][1] * sc;
                    s2 += ((o0[0] * o0[0] + o0[1] * o0[1]) + (o0[2] * o0[2] + o0[3] * o0[3])) + ((o1[0] * o1[0] + o1[1] * o1[1]) + (o1[2] * o1[2] + o1[3] * o1[3]));
                    u32x4 w; w.x = cvt_pk_bf16(o0[0], o0[1]); w.y = cvt_pk_bf16(o0[2], o0[3]); w.z = cvt_pk_bf16(o1[0], o1[1]); w.w = cvt_pk_bf16(o1[2], o1[3]);
                    gst<u32x4>(hb + off + bj * HALF, w);
                }
                s2 += __shfl_xor(s2, 16); s2 += __shfl_xor(s2, 32);
                if (fq == 0) gatomic_add(ss_out + row, s2);
            }
            asm volatile("" ::: "memory");
        }
    }
};
template <class Epi, class Sched, bool ALIGN_EPI = false, bool SP2 = false>
__device__ __forceinline__ void gemm_phase(PG8_LAS unsigned char* lds, const Gemm g, const Sched& S, const Epi& E, int tid_in) {
    int tid_ = tid_in; asm volatile("" : "+v"(tid_));
    const int tid = tid_, wid = __builtin_amdgcn_readfirstlane(tid >> 6), lane = tid & 63, wr = wid >> 2, wc = wid & 3, fr = lane & 15, fq = lane >> 4;
    const int K = g.K, nt = K / BK;
    unsigned voffA[2], voffB[2];
#pragma unroll
    for (int i = 0; i < 2; ++i) { int R, C; stage_rc(tid * 16 + i * 8192, R, C); const int Rb = Epi::PERM ? ((R & ~31) + perm32(R & 31)) : R;
        voffA[i] = (unsigned)(R * K + C) * 2u; voffB[i] = (unsigned)(Rb * K + C) * 2u; }
    const size_t kstep = (size_t)(BK * 2);
    const size_t hstep = (size_t)HALF * K * 2;
    const size_t tstep = 2 * hstep;
    const unsigned ldsw = (unsigned)wid * 1024u;
    const int aoff = lds_byte(wr * 64 + fr, fq * 8), boff = lds_byte(wc * 32 + fr, fq * 8);
#define PG8_SA(b, h) (((b) * 2 + (h)) * HTB)
#define PG8_SB(b, h) ((4 + (b) * 2 + (h)) * HTB)
#define PG8_STAGE(bufoff, gbase, voff) do { _Pragma("unroll") for (int _i = 0; _i < 2; ++_i) \
        __builtin_amdgcn_global_load_lds((const unsigned*)((const char*)(gbase) + (voff)[_i]), (PG8_LAS unsigned*)(lds + (bufoff) + ldsw + _i * 8192), 16, 0, 0); } while (0)
#define PG8_LDA(dst, b, h) do { _Pragma("unroll") for (int m = 0; m < 4; ++m) _Pragma("unroll") for (int k = 0; k < 2; ++k) dst[m][k] = *(const PG8_LAS bf16x8*)(lds + PG8_SA(b, h) + aoff + m * 2048 + k * 1024); } while (0)
#define PG8_LDB(dst, b, h) do { _Pragma("unroll") for (int n = 0; n < 2; ++n) _Pragma("unroll") for (int k = 0; k < 2; ++k) dst[n][k] = *(const PG8_LAS bf16x8*)(lds + PG8_SB(b, h) + boff + n * 2048 + k * 1024); } while (0)
#define PG8_MMA(ai, bj, At, Bt) do { __builtin_amdgcn_s_setprio(1); _Pragma("unroll") for (int m = 0; m < 4; ++m) _Pragma("unroll") for (int n = 0; n < 2; ++n) _Pragma("unroll") for (int k = 0; k < 2; ++k) \
        acc[ai][bj][m][n] = __builtin_amdgcn_mfma_f32_16x16x32_bf16(Bt[n][k], At[m][k], acc[ai][bj][m][n], 0, 0, 0); __builtin_amdgcn_s_setprio(0); } while (0)
#define PG8_WAIT_V(n) asm volatile("s_waitcnt vmcnt(" #n ")" ::: "memory")
#define PG8_WAIT_L(n) asm volatile("s_waitcnt lgkmcnt(" #n ")" ::: "memory")
#define PG8_BAR __builtin_amdgcn_s_barrier()
#define PG8_SCHED __builtin_amdgcn_sched_barrier(0)
    Unit cur, nxt; int ui = 0;
    if (!S.next(0, cur)) return;
    f32x4 acc[2][2][4][2];
#pragma unroll
    for (int a = 0; a < 2; ++a)
#pragma unroll
        for (int b = 0; b < 2; ++b)
#pragma unroll
            for (int m = 0; m < 4; ++m)
#pragma unroll
                for (int n = 0; n < 2; ++n) acc[a][b][m][n] = (f32x4){0.f, 0.f, 0.f, 0.f};
    bf16x8 At[4][2], B0[2][2], B1[2][2];
    const char* cA = (const char*)g.A + (size_t)cur.pm * tstep; const char* cB = (const char*)g.Bt + (size_t)cur.pn * tstep;
    S.a_ready(cur);
    if constexpr (SP2) {
        PG8_STAGE(PG8_SB(0, 0), cB, voffB); PG8_STAGE(PG8_SB(0, 1), cB + hstep, voffB); PG8_STAGE(PG8_SA(0, 0), cA, voffA); PG8_STAGE(PG8_SA(0, 1), cA + hstep, voffA);
        if (wr == 1) PG8_BAR;
        PG8_WAIT_V(2); PG8_BAR;
        PG8_STAGE(PG8_SB(1, 0), cB + kstep, voffB); PG8_STAGE(PG8_SA(1, 0), cA + kstep, voffA); PG8_STAGE(PG8_SB(1, 1), cB + hstep + kstep, voffB);
        PG8_WAIT_V(6); PG8_BAR;
    } else {
        PG8_STAGE(PG8_SB(0, 0), cB, voffB); PG8_STAGE(PG8_SA(0, 0), cA, voffA); PG8_STAGE(PG8_SB(0, 1), cB + hstep, voffB); PG8_STAGE(PG8_SA(0, 1), cA + hstep, voffA);
        if (wr == 1) PG8_BAR;
        PG8_WAIT_V(4); PG8_BAR;
        PG8_STAGE(PG8_SB(1, 0), cB + kstep, voffB); PG8_STAGE(PG8_SA(1, 0), cA + kstep, voffA); PG8_STAGE(PG8_SB(1, 1), cB + hstep + kstep, voffB);
        PG8_WAIT_V(6); PG8_BAR;
    }
    for (;;) {
        const bool has_next = S.next(ui + 1, nxt);
        const char* nA = has_next ? (const char*)g.A + (size_t)nxt.pm * tstep : cA; const char* nB = has_next ? (const char*)g.Bt + (size_t)nxt.pn * tstep : cB;
        constexpr int NHK = Epi::HAS_MID ? 2 : 1;
#pragma unroll
        for (int hk = 0; hk < NHK; ++hk) {
        if constexpr (Epi::HAS_MID) { if (hk == 1) E.mid(acc, cur, wr, fr); }
        const int t_beg = hk * (nt / NHK), t_end = (hk + 1) * (nt / NHK);
        for (int t = t_beg; t < t_end; t += 2) {
            const bool last = (t == nt - 2);
            const char* a1 = cA + (size_t)(t + 1) * kstep;
            const char* a2 = last ? nA : cA + (size_t)(t + 2) * kstep; const char* b2 = last ? nB : cB + (size_t)(t + 2) * kstep;
            const char* a3 = a2 + kstep; const char* b3 = b2 + kstep;
            if (last && has_next) S.a_ready(nxt);
            if constexpr (SP2) {
            PG8_LDB(B0, 0, 0); PG8_LDB(B1, 0, 1); PG8_SCHED; PG8_LDA(At, 0, 0); PG8_STAGE(PG8_SA(1, 1), a1 + hstep, voffA);
            PG8_WAIT_V(8); PG8_WAIT_L(0); PG8_BAR; PG8_MMA(0, 0, At, B0); PG8_MMA(0, 1, At, B1); PG8_BAR; PG8_SCHED;
            PG8_LDA(At, 0, 1); PG8_STAGE(PG8_SB(0, 0), b2, voffB); PG8_STAGE(PG8_SB(0, 1), b2 + hstep, voffB); PG8_STAGE(PG8_SA(0, 0), a2, voffA);
            PG8_WAIT_V(8); PG8_WAIT_L(0); PG8_BAR; PG8_MMA(1, 0, At, B0); PG8_MMA(1, 1, At, B1); PG8_BAR; PG8_SCHED;
            PG8_LDB(B0, 1, 0); PG8_LDB(B1, 1, 1); PG8_SCHED; PG8_LDA(At, 1, 0); PG8_STAGE(PG8_SA(0, 1), a2 + hstep, voffA);
            PG8_WAIT_V(8); PG8_WAIT_L(0); PG8_BAR; PG8_MMA(0, 0, At, B0); PG8_MMA(0, 1, At, B1); PG8_BAR; PG8_SCHED;
            PG8_LDA(At, 1, 1); PG8_STAGE(PG8_SB(1, 0), b3, voffB); PG8_STAGE(PG8_SB(1, 1), b3 + hstep, voffB); PG8_STAGE(PG8_SA(1, 0), a3, voffA);
            PG8_WAIT_V(8); PG8_WAIT_L(0); PG8_BAR; PG8_MMA(1, 0, At, B0); PG8_MMA(1, 1, At, B1); PG8_BAR; PG8_SCHED;
            } else {
            PG8_LDB(B0, 0, 0); PG8_SCHED; PG8_LDA(At, 0, 0); PG8_STAGE(PG8_SA(1, 1), a1 + hstep, voffA);
            PG8_WAIT_L(8); PG8_BAR; PG8_WAIT_L(0); PG8_MMA(0, 0, At, B0); PG8_BAR; PG8_SCHED;
            PG8_LDB(B1, 0, 1); PG8_STAGE(PG8_SB(0, 0), b2, voffB);
            PG8_BAR; PG8_WAIT_L(0); PG8_MMA(0, 1, At, B1); PG8_BAR;
            PG8_LDA(At, 0, 1); PG8_STAGE(PG8_SA(0, 0), a2, voffA);
            PG8_BAR; PG8_WAIT_L(0); PG8_MMA(1, 0, At, B0); PG8_BAR; PG8_SCHED;
            PG8_STAGE(PG8_SB(0, 1), b2 + hstep, voffB);
            PG8_WAIT_V(6); PG8_BAR; PG8_MMA(1, 1, At, B1); PG8_BAR;
            PG8_LDB(B0, 1, 0); PG8_SCHED; PG8_LDA(At, 1, 0); PG8_STAGE(PG8_SA(0, 1), a2 + hstep, voffA);
            PG8_WAIT_L(8); PG8_BAR; PG8_WAIT_L(0); PG8_MMA(0, 0, At, B0); PG8_BAR; PG8_SCHED;
            PG8_LDB(B1, 1, 1); PG8_STAGE(PG8_SB(1, 0), b3, voffB);
            PG8_BAR; PG8_WAIT_L(0); PG8_MMA(0, 1, At, B1); PG8_BAR;
            PG8_LDA(At, 1, 1); PG8_STAGE(PG8_SA(1, 0), a3, voffA);
            PG8_BAR; PG8_WAIT_L(0); PG8_MMA(1, 0, At, B0); PG8_BAR; PG8_SCHED;
            PG8_STAGE(PG8_SB(1, 1), b3 + hstep, voffB);
            PG8_WAIT_V(6); PG8_BAR; PG8_MMA(1, 1, At, B1); PG8_BAR;
            }
        }
        }
        if constexpr (ALIGN_EPI) { if (wr == 0) PG8_BAR; }
        if constexpr (!Epi::AFTER_DRAIN) { E(acc, cur, wr, wc, fr, fq); S.done(cur); }
        if (!has_next) break;
#pragma unroll
        for (int a = 0; a < 2; ++a)
#pragma unroll
            for (int b = 0; b < 2; ++b)
#pragma unroll
                for (int m = 0; m < 4; ++m)
#pragma unroll
                    for (int n = 0; n < 2; ++n) acc[a][b][m][n] = (f32x4){0.f, 0.f, 0.f, 0.f};
        cur = nxt; cA = nA; cB = nB; ++ui;
        if constexpr (ALIGN_EPI) { if (wr == 1) PG8_BAR; }
    }
    PG8_WAIT_V(0);
    if constexpr (!ALIGN_EPI) { if (wr == 0) PG8_BAR; }
    PG8_BAR;
    if constexpr (Epi::AFTER_DRAIN) { E.fused(acc, cur, wr, wc, fr, fq, lds, wid, lane); S.done(cur); }
#undef PG8_SA
#undef PG8_SB
#undef PG8_STAGE
#undef PG8_LDA
#undef PG8_LDB
#undef PG8_MMA
#undef PG8_WAIT_V
#undef PG8_WAIT_L
#undef PG8_BAR
#undef PG8_SCHED
}
}
constexpr int NWAVES = 8;
constexpr int M = 16384, D = 2048, FF = 5632, SEQ = 2048, NB = 8, LW = 1024;
constexpr int N_PHASES = 11;
#ifndef MK_COOP
#define MK_COOP 1
#endif
constexpr size_t MiB = 1u << 20;
constexpr size_t WS_SS = 0;
constexpr size_t WS_SP8 = 6 * 65536;
constexpr size_t WS_BAR = 768 * 1024;
constexpr size_t WS_GWP = 1 * MiB;
constexpr size_t WS_AGG = 2 * MiB;
constexpr size_t WS_W1I = 8 * MiB, WS_W1O = 52 * MiB, WS_WMI = 74 * MiB, WS_WMO = 94 * MiB, WS_W2I = 102 * MiB, WS_W2O = 146 * MiB;
constexpr size_t WS_HB = 168 * MiB;
constexpr size_t WS_Y = 232 * MiB;
constexpr size_t WS_ACT = 296 * MiB;
constexpr size_t WS_END = 472 * MiB;

#define LAS __attribute__((address_space(3)))
using pg8::gld; using pg8::gld_nt; using pg8::gst; using pg8::gst_nt; using pg8::gatomic_add;
typedef unsigned short bf16_t;
typedef short bf16x8 __attribute__((ext_vector_type(8)));
typedef float f32x4 __attribute__((ext_vector_type(4)));
typedef unsigned u32x4 __attribute__((ext_vector_type(4)));
typedef unsigned u32x2 __attribute__((ext_vector_type(2)));
constexpr int RING_BYTES = 131072;
constexpr int LDS_BYTES = 163840;
constexpr int L_BARST = LDS_BYTES - 64;

#define LDS_WAIT() asm volatile("s_waitcnt lgkmcnt(0)" ::: "memory")
#define SCHED_FENCE() __builtin_amdgcn_sched_barrier(0)
__device__ __forceinline__ unsigned pk2(float lo, float hi) { return pg8::cvt_pk_bf16(lo, hi); }
__device__ __forceinline__ float bf_lo(unsigned w) { return __uint_as_float(w << 16); }
__device__ __forceinline__ float bf_hi(unsigned w) { return __uint_as_float(w & 0xffff0000u); }
__device__ __forceinline__ float wave_sum(float v) {
#pragma unroll
    for (int o = 1; o < 64; o <<= 1) v += __shfl_xor(v, o);
    return v;
}
__device__ __forceinline__ bf16x8 mk8(float a0, float a1, float a2, float a3, float a4, float a5, float a6, float a7) {
    u32x4 w; w.x = pk2(a0, a1); w.y = pk2(a2, a3); w.z = pk2(a4, a5); w.w = pk2(a6, a7);
    return __builtin_bit_cast(bf16x8, w);
}
#define MFMA16(x, y, c) __builtin_amdgcn_mfma_f32_16x16x32_bf16((x), (y), (c), 0, 0, 0)

#define XB_TMO      128
#define XB_XCNT(j)  (256  + 64 * (j))
#define XB_XSUB(j)  (1280 + 64 * (j))
#define XB_XGEN(j)  (2304 + 64 * (j))
#define XB_TOP      3328
#define XB_TOPGEN   3392
#define XCD_BAR_WORDS 3456
#define XB_SPIN_CAP (1u << 18)

__device__ __forceinline__ unsigned xb_ld(unsigned* p)              { return __hip_atomic_load(p, __ATOMIC_RELAXED, __HIP_MEMORY_SCOPE_AGENT); }
__device__ __forceinline__ unsigned xb_add(unsigned* p, unsigned v) { return __hip_atomic_fetch_add(p, v, __ATOMIC_RELAXED, __HIP_MEMORY_SCOPE_AGENT); }
__device__ __forceinline__ unsigned xb_xcc_id() { return (unsigned)__builtin_amdgcn_s_getreg((3 << 11) | 20) & 0xFu; }
#define XB_SPIN(cond, bar) do { unsigned _sp = 0; while (cond) { __builtin_amdgcn_s_sleep(1); \
    if ((++_sp & 255u) == 0u) { if (xb_ld(&(bar)[XB_TMO])) break; if (_sp > XB_SPIN_CAP) { atomicAdd(&(bar)[XB_TMO], 1u); break; } } } } while (0)

struct XcdBarrier {
    unsigned* bar; unsigned x;
    volatile LAS unsigned* st;
};

__device__ __forceinline__ XcdBarrier xcd_barrier_post(unsigned* bar, volatile LAS unsigned* st, int tid) {
    XcdBarrier b; b.bar = bar; b.x = xb_xcc_id(); b.st = st;
    if (tid == 0) (void)xb_add(&bar[XB_XCNT(b.x)], 1u);
    return b;
}
__device__ __forceinline__ void xcd_barrier_complete(unsigned* bar, unsigned x, unsigned& nloc, unsigned& nx) {
    const unsigned G = gridDim.x * gridDim.y * gridDim.z;
    unsigned sum, cnt, mine, sp = 0u;
    for (;;) {
        sum = 0u; cnt = 0u; mine = 0u;
#pragma unroll
        for (unsigned j = 0; j < 16; ++j) { const unsigned c = xb_ld(&bar[XB_XCNT(j)]); sum += c; cnt += (c > 0u) ? 1u : 0u; mine = (j == x) ? c : mine; }
        if (sum == G) break;
        __builtin_amdgcn_s_sleep(1);
        if ((++sp & 255u) == 0u) { if (xb_ld(&bar[XB_TMO])) break; if (sp > XB_SPIN_CAP) { atomicAdd(&bar[XB_TMO], 1u); break; } }
    }
    nloc = mine > 0u ? mine : 1u; nx = cnt > 0u ? cnt : 1u;
}

__device__ __forceinline__ void xcd_barrier(const XcdBarrier& b, int tid) {
    asm volatile("s_waitcnt vmcnt(0)" ::: "memory");
    __syncthreads();
    if (tid == 0) {
        unsigned* bar = b.bar;
        __builtin_amdgcn_s_waitcnt(0);
        unsigned nloc = b.st[0], nx = b.st[1];
        if (nloc == 0u) { xcd_barrier_complete(bar, b.x, nloc, nx); b.st[0] = nloc; b.st[1] = nx; }
        const unsigned old = xb_add(&bar[XB_XSUB(b.x)], 1u);
        const unsigned gen = old / nloc;
        if (old + 1u == (gen + 1u) * nloc) {
            __builtin_amdgcn_fence(__ATOMIC_RELEASE, "agent");
            asm volatile("s_waitcnt vmcnt(0)" ::: "memory");
            const unsigned og = xb_add(&bar[XB_TOP], 1u);
            const unsigned tg = og / nx;
            if (og + 1u == (tg + 1u) * nx) xb_add(&bar[XB_TOPGEN], 1u);
            else XB_SPIN(xb_ld(&bar[XB_TOPGEN]) == tg, bar);
            __builtin_amdgcn_fence(__ATOMIC_ACQUIRE, "agent");
            xb_add(&bar[XB_XGEN(b.x)], 1u);
            asm volatile("s_waitcnt vmcnt(0)" ::: "memory");
        } else {
            XB_SPIN(xb_ld(&bar[XB_XGEN(b.x)]) == gen, bar);
            __builtin_amdgcn_fence(__ATOMIC_ACQUIRE, "agent");
            asm volatile("s_waitcnt vmcnt(0)" ::: "memory");
        }
    }
    __syncthreads();
}

struct Args { const float* in[19]; float* out; unsigned char* ws; int ph_lo, ph_hi, coop, pad; };
typedef const __attribute__((address_space(4))) Args* KArgs;

struct P0Item { const float* W; const float* gk; bf16_t* WT; int K, N, dest_row0, k0, n0; };
__device__ __forceinline__ int swiglu_dest(int n0) { return n0 < FF ? (n0 >> 7) * 256 + (n0 & 127) : ((n0 - FF) >> 7) * 256 + 128 + ((n0 - FF) & 127); }
__device__ __forceinline__ P0Item p0_decode(KArgs a, unsigned char* ws, int it) {
    constexpr int I_FI = (D / 64) * (2 * FF / 64), I_FO = (FF / 64) * (D / 64), I_MI = (D / 64) * (5120 / 64);
    int r = it; P0Item I;
    if (r < 2 * I_FI) { const bool f1 = r < I_FI; if (!f1) r -= I_FI; const int nblk = 2 * FF / 64, kb = r / nblk, nb = r % nblk;
        I.W = a->in[f1 ? 2 : 16]; I.gk = a->in[f1 ? 1 : 15] + 64 * kb; I.WT = (bf16_t*)(ws + (f1 ? WS_W1I : WS_W2I)); I.K = D; I.N = 2 * FF; I.dest_row0 = swiglu_dest(64 * nb); I.k0 = 64 * kb; I.n0 = 64 * nb; return I; }
    r -= 2 * I_FI;
    if (r < 2 * I_FO) { const bool f1 = r < I_FO; if (!f1) r -= I_FO; const int nblk = D / 64, kb = r / nblk, nb = r % nblk;
        I.W = a->in[f1 ? 3 : 17]; I.gk = nullptr; I.WT = (bf16_t*)(ws + (f1 ? WS_W1O : WS_W2O)); I.K = FF; I.N = D; I.dest_row0 = 64 * nb; I.k0 = 64 * kb; I.n0 = 64 * nb; return I; }
    r -= 2 * I_FO;
    if (r < I_MI) { const int nblk = 5120 / 64, kb = r / nblk, nb = r % nblk;
        I.W = a->in[5]; I.gk = a->in[4] + 64 * kb; I.WT = (bf16_t*)(ws + WS_WMI); I.K = D; I.N = 5120; I.dest_row0 = 64 * nb; I.k0 = 64 * kb; I.n0 = 64 * nb; return I; }
    r -= I_MI;
    { const int nblk = D / 64, kb = r / nblk, nb = r % nblk;
      I.W = a->in[14]; I.gk = (kb < 16) ? a->in[12] + 64 * kb : a->in[13] + 64 * (kb - 16); I.WT = (bf16_t*)(ws + WS_WMO); I.K = D; I.N = D; I.dest_row0 = 64 * nb; I.k0 = 64 * kb; I.n0 = 64 * nb; return I; }
}
__device__ __forceinline__ void p0_load(const P0Item& I, int lane, f32x4 (&v)[16], float (&g)[16]) {
    const int lr = lane >> 4, lc = (lane & 15) * 4;
#pragma unroll
    for (int i = 0; i < 16; ++i) { v[i] = gld_nt<f32x4>(I.W + (size_t)(I.k0 + 4 * i + lr) * I.N + I.n0 + lc); g[i] = I.gk ? gld<float>(I.gk + 4 * i + lr) : 1.0f; }
}
__device__ __forceinline__ void p0_finish(const P0Item& I, LAS float* scr, int lane, const f32x4 (&v)[16], const float (&g)[16]) {
    const int lr = lane >> 4, lc = (lane & 15) * 4;
#pragma unroll
    for (int i = 0; i < 16; ++i) { LAS float* d = scr + (4 * i + lr) * 65 + lc; d[0] = v[i][0] * g[i]; d[1] = v[i][1] * g[i]; d[2] = v[i][2] * g[i]; d[3] = v[i][3] * g[i]; }
    LDS_WAIT(); asm volatile("" ::: "memory");
    const int c = lane & 7;
#pragma unroll
    for (int j = 0; j < 8; ++j) { const int n = (lane >> 3) + 8 * j; const LAS float* s = scr + (8 * c) * 65 + n;
        u32x4 o; o.x = pk2(s[0 * 65], s[1 * 65]); o.y = pk2(s[2 * 65], s[3 * 65]); o.z = pk2(s[4 * 65], s[5 * 65]); o.w = pk2(s[6 * 65], s[7 * 65]);
        gst<u32x4>(I.WT + (size_t)(I.dest_row0 + n) * I.K + I.k0 + 8 * c, o); }
    LDS_WAIT(); asm volatile("" ::: "memory");
}

__device__ __forceinline__ void p0_prologue(KArgs a, unsigned char* ws, LAS unsigned char* lds, int wave, int lane, int bx) {
    LAS float* scr = (LAS float*)(lds + wave * 16640);
    const int gw = bx * NWAVES + wave, NGW = gridDim.x * NWAVES;
    constexpr int I_FI = (D / 64) * (2 * FF / 64), I_FO = (FF / 64) * (D / 64), I_MI = (D / 64) * (5120 / 64), I_MO = (D / 64) * (D / 64);
    constexpr int NITEMS = 2 * (I_FI + I_FO) + I_MI + I_MO;
    {
        int it = gw;
        if (it < NITEMS) {
            P0Item cur = p0_decode(a, ws, it); f32x4 va[16]; float ga[16];
            p0_load(cur, lane, va, ga);
            for (;;) {
                const int nit = it + NGW; const bool has = nit < NITEMS;
                P0Item nxt = cur; f32x4 vb[16]; float gb[16];
                if (has) { nxt = p0_decode(a, ws, nit); p0_load(nxt, lane, vb, gb); }
                p0_finish(cur, scr, lane, va, ga);
                if (!has) break;
                cur = nxt; it = nit;
#pragma unroll
                for (int i = 0; i < 16; ++i) { va[i] = vb[i]; ga[i] = gb[i]; }
            }
        }
    }
    float* ssx = (float*)(ws + WS_SS);
    for (int m0 = gw; m0 < M; m0 += 4 * NGW) {
        int mr[4]; f32x4 v[4][8];
#pragma unroll
        for (int q = 0; q < 4; ++q) { mr[q] = (m0 + q * NGW < M) ? m0 + q * NGW : m0;
#pragma unroll
            for (int j = 0; j < 8; ++j) v[q][j] = gld_nt<f32x4>((const f32x4*)(a->in[0] + (size_t)mr[q] * D) + lane + 64 * j); }
#pragma unroll
        for (int q = 0; q < 4; ++q) {
            float s = 0.f;
#pragma unroll
            for (int j = 0; j < 8; ++j) s += (v[q][j][0] * v[q][j][0] + v[q][j][1] * v[q][j][1]) + (v[q][j][2] * v[q][j][2] + v[q][j][3] * v[q][j][3]);
            s = wave_sum(s);
            if (q == 0 || mr[q] != m0) {
                if (lane == 0) gst<float>(ssx + mr[q], s);
                u32x2* o8 = (u32x2*)((bf16_t*)(ws + WS_HB) + (size_t)mr[q] * D) + lane;
#pragma unroll
                for (int j = 0; j < 8; ++j) { u32x2 p; p.x = pk2(v[q][j][0], v[q][j][1]); p.y = pk2(v[q][j][2], v[q][j][3]); gst<u32x2>(o8 + 64 * j, p); }
            }
        }
    }
    const int gt = bx * (NWAVES * 64) + wave * 64 + lane, NGT = gridDim.x * NWAVES * 64;
    { float* z = (float*)(ws + WS_SS) + 16384; for (int i = gt; i < 5 * 16384; i += NGT) gst<float>(z + i, 0.f); }
    { float* sp8 = (float*)(ws + WS_SP8); for (int i = gt; i < 2048; i += NGT) gst<float>(sp8 + i, 8.0f * 1.44269504089f * log1pf(expf(-gld<float>(a->in[10] + i)))); }
    {
        const float* gw_ = a->in[8]; u32x4* gwp = (u32x4*)(ws + WS_GWP);
        for (int idx = gt; idx < 32768; idx += NGT) {
            const int ln = idx & 63, ks = (idx >> 6) & 1, jb = (idx >> 7) & 3, g = (idx >> 9) & 1, z = (idx >> 10) & 1, h = idx >> 11;
            const int fr = ln & 15, fq = ln >> 4; float v[8];
#pragma unroll
            for (int s = 0; s < 8; ++s) { const int i = 16 * (2 * ks + (s >> 2)) + 4 * fq + (s & 3), j = 16 * jb + fr; v[s] = -1.44269504089f * gld<float>(gw_ + ((size_t)(((z * 2 + g) * 16 + h) * 64 + i)) * 64 + j); }
            u32x4 w; w.x = pk2(v[0], v[1]); w.y = pk2(v[2], v[3]); w.z = pk2(v[4], v[5]); w.w = pk2(v[6], v[7]); gst<u32x4>(gwp + idx, w);
        }
    }
}

__device__ __forceinline__ float sigm(float x) { return __builtin_amdgcn_rcpf(1.0f + __builtin_amdgcn_exp2f(x * -1.44269504089f)); }
template <int CTRL> __device__ __forceinline__ float dpp_f(float old, float src) {
    return __builtin_bit_cast(float, __builtin_amdgcn_update_dpp(__builtin_bit_cast(int, old), __builtin_bit_cast(int, src), CTRL, 0xF, 0xF, false));
}
template <int DIR, int DD> __device__ __forceinline__ void scan_step(float& av, float& bv) {
    constexpr int CTRL = (DIR == 0 ? 0x110 : 0x100) + DD;
    const float bp = dpp_f<CTRL>(0.0f, bv), ap = dpp_f<CTRL>(1.0f, av);
    bv = av * bp + bv; av = av * ap;
}
__device__ __forceinline__ float neg_expm1(float x) {
    const float p = -x * (1.0f + x * 0.5f * (1.0f + x * (1.0f / 3.0f) * (1.0f + x * 0.25f * (1.0f + x * 0.2f * (1.0f + x * (1.0f / 6.0f))))));
    return x > -0.3f ? p : 1.0f - __expf(x);
}
struct LruCtx { const bf16_t* xl; const bf16_t* gl; const float* convw; const float* convb; const u32x4* gwp; const float* gateb; const float* sp8; float* aggA; float* aggB; bf16_t* y; float* ssA; };

constexpr int L_GWP = 0, L_CW = 32768, L_CB = 33792, L_GB = 34048, L_SP = 35072, L_HF = 36864, L_HF_WAVE = 8192, L_RPB = 102400;
constexpr int XT_ROWB = 144, XT_TILE = 3584, L_XT2 = 102400, L_XT2_WAVE = 7168;
static_assert(L_XT2 + NWAVES * L_XT2_WAVE <= L_BARST && 2 * XT_TILE <= L_XT2_WAVE && 2 * XT_TILE <= L_HF_WAVE, "LDS map (x tiles)");
static_assert(L_HF + NWAVES * L_HF_WAVE == L_RPB && L_RPB + 16 * 15 * 32 * 4 <= LDS_BYTES, "LDS map");
__device__ __forceinline__ void lru_stage_consts(const LruCtx& C, LAS unsigned char* lds, int h, int tid) {
    LAS u32x4* g = (LAS u32x4*)(lds + L_GWP);
    for (int i = tid; i < 2048; i += NWAVES * 64) g[i] = gld<u32x4>(C.gwp + (size_t)h * 2048 + i);
    LAS float* cw = (LAS float*)(lds + L_CW); LAS float* cb = (LAS float*)(lds + L_CB); LAS float* gb = (LAS float*)(lds + L_GB); LAS float* sp = (LAS float*)(lds + L_SP);
    if (tid < 256) cw[tid] = gld<float>(C.convw + (tid >> 6) * LW + h * 64 + (tid & 63));
    if (tid < 64) cb[tid] = gld<float>(C.convb + h * 64 + tid);
    if (tid < 256) gb[tid] = -1.44269504089f * gld<float>(C.gateb + ((tid >> 6) * 16 + h) * 64 + (tid & 63));
    if (tid < 128) sp[tid] = gld<float>(C.sp8 + (tid >> 6) * LW + h * 64 + (tid & 63));
}
struct XRegs { u32x4 v[3]; };
__device__ __forceinline__ void lru_ldx(XRegs& R, const LruCtx& C, int b, int h, int s0, int lane) {
#pragma unroll
    for (int i = 0; i < 3; ++i) { const int s = s0 - 2 + 8 * i + (lane >> 3); const bool ok = (s >= 0) && (s < SEQ);
        const u32x4 v = gld<u32x4>(C.xl + ((size_t)(b * SEQ + (ok ? s : s0))) * LW + h * 64 + (lane & 7) * 8);
        R.v[i] = ok ? v : (u32x4){0u, 0u, 0u, 0u}; }
}
__device__ __forceinline__ void lru_stx(const XRegs& R, int lane, LAS unsigned char* xt) {
#pragma unroll
    for (int i = 0; i < 3; ++i) *(LAS u32x4*)(xt + (8 * i + (lane >> 3)) * XT_ROWB + (lane & 7) * 16) = R.v[i];
}
struct ConvRegs { f32x4 w[4]; f32x4 b; u32x2 x[4]; };
struct GateRegs { u32x4 g[4]; f32x4 br, bi, sp; u32x2 hf; };
__device__ __forceinline__ void ld_conv(ConvRegs& R, const LAS float* cw, const LAS float* cb, const LAS unsigned char* xrow, int jb) {
    R.b = *(const LAS f32x4*)(cb + 16 * jb);
#pragma unroll
    for (int tap = 0; tap < 4; ++tap) { R.w[tap] = *(const LAS f32x4*)(cw + tap * 64 + 16 * jb); R.x[tap] = *(const LAS u32x2*)(xrow + tap * XT_ROWB + 32 * jb); }
}
template <bool WITH_HF>
__device__ __forceinline__ void ld_gate(GateRegs& R, const LAS u32x4* gw, const LAS float* gb, const LAS float* sp_, const LAS unsigned* hfl, int hidx, int jb) {
    R.g[0] = gw[(0 * 4 + jb) * 2 * 64]; R.g[1] = gw[(0 * 4 + jb) * 2 * 64 + 64]; R.g[2] = gw[(1 * 4 + jb) * 2 * 64]; R.g[3] = gw[(1 * 4 + jb) * 2 * 64 + 64];
    R.br = *(const LAS f32x4*)(gb + 16 * jb); R.bi = *(const LAS f32x4*)(gb + 64 + 16 * jb); R.sp = *(const LAS f32x4*)(sp_ + 16 * jb);
    if (WITH_HF) { R.hf.x = hfl[hidx + (jb * 2 + 0) * 64]; R.hf.y = hfl[hidx + (jb * 2 + 1) * 64]; }
}
template <int PASS, int DIR, int MODE>
__device__ __forceinline__ void lru_step(const LruCtx& C, const LAS unsigned char* cst, const LAS unsigned char* xt, int b, int h, int chunk, int tbi, int lane, float (&carry)[4][4], float (&atot)[4][4], LAS unsigned* hfl) {
    const int fr = lane & 15, fq = lane >> 4;
    const int s_tok = chunk * 64 + tbi * 16 + fr;
    const size_t rowoff = ((size_t)(b * SEQ + s_tok)) * LW + h * 64 + 4 * fq;
    u32x2 gr[4];
    if (PASS == 2 && MODE == 1) {
#pragma unroll
        for (int jb = 0; jb < 4; ++jb) gr[jb] = gld<u32x2>(C.gl + rowoff + 16 * jb);
    }
    const LAS unsigned char* xrow = xt + fr * XT_ROWB + 8 * fq;
    const LAS float* cw = (const LAS float*)(cst + L_CW) + 4 * fq; const LAS float* cb = (const LAS float*)(cst + L_CB) + 4 * fq;
    const LAS float* gb = (const LAS float*)(cst + L_GB) + (DIR * 2) * 64 + 4 * fq; const LAS float* sp_ = (const LAS float*)(cst + L_SP) + DIR * 64 + 4 * fq;
    const LAS u32x4* gw = (const LAS u32x4*)(cst + L_GWP) + (size_t)(DIR * 2) * 8 * 64 + lane;
    float xc[4][4];
    {
        ConvRegs ca; ld_conv(ca, cw, cb, xrow, 0);
#pragma unroll
        for (int jb = 0; jb < 4; ++jb) {
            ConvRegs cn; if (jb < 3) ld_conv(cn, cw, cb, xrow, jb + 1);
            SCHED_FENCE();
            f32x4 av = ca.b;
#pragma unroll
            for (int tap = 0; tap < 4; ++tap) { const u32x2 raw = ca.x[tap]; av = av + ca.w[tap] * (f32x4){bf_lo(raw.x), bf_hi(raw.x), bf_lo(raw.y), bf_hi(raw.y)}; }
#pragma unroll
            for (int e = 0; e < 4; ++e) xc[jb][e] = av[e];
            SCHED_FENCE();
            if (jb < 3) ca = cn;
        }
    }
    const bf16x8 xb0 = mk8(xc[0][0], xc[0][1], xc[0][2], xc[0][3], xc[1][0], xc[1][1], xc[1][2], xc[1][3]);
    const bf16x8 xb1 = mk8(xc[2][0], xc[2][1], xc[2][2], xc[2][3], xc[3][0], xc[3][1], xc[3][2], xc[3][3]);
    float ssq = 0.f;
    constexpr bool WHF = (PASS == 2 && MODE == 1);
    const int hidx = tbi * 8 * 64 + lane;
    GateRegs ga; ld_gate<WHF>(ga, gw, gb, sp_, hfl, hidx, 0);
#pragma unroll
    for (int jb = 0; jb < 4; ++jb) {
        GateRegs gn; if (jb < 3) ld_gate<WHF>(gn, gw, gb, sp_, hfl, hidx, jb + 1);
        SCHED_FENCE();
        const f32x4 sp = ga.sp;
        f32x4 ar = ga.br, ai = ga.bi;
        ar = MFMA16(__builtin_bit_cast(bf16x8, ga.g[0]), xb0, ar); ar = MFMA16(__builtin_bit_cast(bf16x8, ga.g[1]), xb1, ar);
        ai = MFMA16(__builtin_bit_cast(bf16x8, ga.g[2]), xb0, ai); ai = MFMA16(__builtin_bit_cast(bf16x8, ga.g[3]), xb1, ai);
        float hv[4];
#pragma unroll
        for (int e = 0; e < 4; ++e) {
            const float rg = __builtin_amdgcn_rcpf(1.0f + __builtin_amdgcn_exp2f(ar[e])), ig = __builtin_amdgcn_rcpf(1.0f + __builtin_amdgcn_exp2f(ai[e]));
            float av = __builtin_amdgcn_exp2f(-rg * sp[e]);
            float bv = __builtin_amdgcn_sqrtf(fmaxf(1.0f - av * av, 0.0f)) * (ig * xc[jb][e]);
            scan_step<DIR, 1>(av, bv); scan_step<DIR, 2>(av, bv); scan_step<DIR, 4>(av, bv); scan_step<DIR, 8>(av, bv);
            hv[e] = bv + av * carry[jb][e];
            carry[jb][e] = dpp_f<(DIR == 0 ? 0x15F : 0x150)>(0.0f, hv[e]);
            if (PASS == 1) atot[jb][e] = atot[jb][e] * dpp_f<(DIR == 0 ? 0x15F : 0x150)>(1.0f, av);
        }
        if (PASS == 2 && MODE == 0) { hfl[(tbi * 8 + jb * 2 + 0) * 64 + lane] = pk2(hv[0], hv[1]); hfl[(tbi * 8 + jb * 2 + 1) * 64 + lane] = pk2(hv[2], hv[3]); }
        if (PASS == 2 && MODE == 1) {
            const unsigned h01 = ga.hf.x, h23 = ga.hf.y;
            const float ho[4] = {bf_lo(h01), bf_hi(h01), bf_lo(h23), bf_hi(h23)};
            const float gvv[4] = {bf_lo(gr[jb].x), bf_hi(gr[jb].x), bf_lo(gr[jb].y), bf_hi(gr[jb].y)};
            float yo[4];
#pragma unroll
            for (int e = 0; e < 4; ++e) { const float g = gvv[e]; const float ge = g * sigm(1.5957691216f * (g + 0.044715f * g * g * g)); yo[e] = ge * (ho[e] + hv[e]); ssq += yo[e] * yo[e]; }
            u32x2 w; w.x = pk2(yo[0], yo[1]); w.y = pk2(yo[2], yo[3]);
            gst<u32x2>(C.y + ((size_t)(b * SEQ + s_tok)) * D + h * 64 + 16 * jb + 4 * fq, w);
        }
        SCHED_FENCE();
        if (jb < 3) ga = gn;
    }
    if (PASS == 2 && MODE == 1) { ssq += __shfl_xor(ssq, 16); ssq += __shfl_xor(ssq, 32); if (fq == 0) gatomic_add(C.ssA + b * SEQ + s_tok, ssq); }
}

struct AggRegs { f32x4 A0[4], B0[4], A1[4], B1[4]; };
template <int DIR>
__device__ __forceinline__ void lru_ld_agg(AggRegs& R, const LruCtx& C, int b, int h, int chunk, int lane) {
    const int fr = lane & 15, fq = lane >> 4;
    const int n = DIR == 0 ? chunk : 31 - chunk;
    const int k0 = 2 * fr, k1 = 2 * fr + 1;
    const int c0 = DIR == 0 ? k0 : 31 - k0, c1 = DIR == 0 ? k1 : 31 - k1;
    const bool ok0 = k0 < n, ok1 = k1 < n;
    const size_t o0 = ((size_t)((DIR * NB + b) * 32 + (ok0 ? c0 : chunk))) * LW + h * 64 + 4 * fq, o1 = ((size_t)((DIR * NB + b) * 32 + (ok1 ? c1 : chunk))) * LW + h * 64 + 4 * fq;
#pragma unroll
    for (int jb = 0; jb < 4; ++jb) { R.A0[jb] = gld<f32x4>(C.aggA + o0 + 16 * jb); R.B0[jb] = gld<f32x4>(C.aggB + o0 + 16 * jb); R.A1[jb] = gld<f32x4>(C.aggA + o1 + 16 * jb); R.B1[jb] = gld<f32x4>(C.aggB + o1 + 16 * jb); }
}
template <int DIR>
__device__ __forceinline__ void lru_fold_agg(const AggRegs& R, int chunk, int lane, float (&carry)[4][4]) {
    const int fr = lane & 15;
    const int n = DIR == 0 ? chunk : 31 - chunk;
    const bool ok0 = 2 * fr < n, ok1 = 2 * fr + 1 < n;
#pragma unroll
    for (int jb = 0; jb < 4; ++jb)
#pragma unroll
        for (int e = 0; e < 4; ++e) {
            const float a0 = ok0 ? R.A0[jb][e] : 1.0f, b0 = ok0 ? R.B0[jb][e] : 0.0f, a1 = ok1 ? R.A1[jb][e] : 1.0f, b1 = ok1 ? R.B1[jb][e] : 0.0f;
            float av = a0 * a1, bv = a1 * b0 + b1;
            scan_step<0, 1>(av, bv); scan_step<0, 2>(av, bv); scan_step<0, 4>(av, bv); scan_step<0, 8>(av, bv);
            carry[jb][e] = dpp_f<0x15F>(0.0f, bv);
        }
}
template <int PASS>
__device__ __forceinline__ void lru_unit(const LruCtx& C, int b, int h, int chunk, int lane, const LAS unsigned char* cst_, LAS unsigned char* wl, LAS unsigned char* xt) {
    const int fr = lane & 15, fq = lane >> 4;
    LAS unsigned* hfl = (LAS unsigned*)wl;
    float cf[4][4], cb[4][4], af[4][4], ab[4][4];
#pragma unroll
    for (int jb = 0; jb < 4; ++jb)
#pragma unroll
        for (int e = 0; e < 4; ++e) { cf[jb][e] = 0.f; cb[jb][e] = 0.f; af[jb][e] = 1.f; ab[jb][e] = 1.f; }
    if (PASS == 2) { AggRegs rf, rb; lru_ld_agg<0>(rf, C, b, h, chunk, lane); lru_ld_agg<1>(rb, C, b, h, chunk, lane); SCHED_FENCE(); lru_fold_agg<0>(rf, chunk, lane, cf); SCHED_FENCE(); lru_fold_agg<1>(rb, chunk, lane, cb); SCHED_FENCE(); }
    unsigned co = 0;
    if (PASS == 1) {
        XRegs x0, x1; lru_ldx(x0, C, b, h, chunk * 64, lane); lru_ldx(x1, C, b, h, chunk * 64 + 48, lane);
#pragma unroll 1
        for (int t = 0; t < 4; ++t) {
            asm volatile("" : "+s"(co));
            const LAS unsigned char* cst = cst_ + co;
            lru_stx(x0, lane, xt); lru_stx(x1, lane, xt + XT_TILE);
            { const int tn = t < 3 ? t + 1 : 3; lru_ldx(x0, C, b, h, chunk * 64 + tn * 16, lane); lru_ldx(x1, C, b, h, chunk * 64 + (3 - tn) * 16, lane); }
            SCHED_FENCE();
            lru_step<1, 0, 0>(C, cst, xt, b, h, chunk, t, lane, cf, af, hfl);
            lru_step<1, 1, 0>(C, cst, xt + XT_TILE, b, h, chunk, 3 - t, lane, cb, ab, hfl);
        }
        if (fr == 0) {
            const size_t o0 = ((size_t)((0 * NB + b) * 32 + chunk)) * LW + h * 64 + 4 * fq, o1 = ((size_t)((1 * NB + b) * 32 + chunk)) * LW + h * 64 + 4 * fq;
#pragma unroll
            for (int jb = 0; jb < 4; ++jb) {
                gst<f32x4>(C.aggA + o0 + 16 * jb, (f32x4){af[jb][0], af[jb][1], af[jb][2], af[jb][3]}); gst<f32x4>(C.aggB + o0 + 16 * jb, (f32x4){cf[jb][0], cf[jb][1], cf[jb][2], cf[jb][3]});
                gst<f32x4>(C.aggA + o1 + 16 * jb, (f32x4){ab[jb][0], ab[jb][1], ab[jb][2], ab[jb][3]}); gst<f32x4>(C.aggB + o1 + 16 * jb, (f32x4){cb[jb][0], cb[jb][1], cb[jb][2], cb[jb][3]});
            }
        }
    } else {
        XRegs x0, x1; lru_ldx(x0, C, b, h, chunk * 64, lane); lru_ldx(x1, C, b, h, chunk * 64 + 48, lane);
#pragma unroll 1
        for (int t = 0; t < 2; ++t) {
            asm volatile("" : "+s"(co));
            const LAS unsigned char* cst = cst_ + co;
            lru_stx(x0, lane, xt); lru_stx(x1, lane, xt + XT_TILE);
            lru_ldx(x0, C, b, h, chunk * 64 + (t + 1) * 16, lane); lru_ldx(x1, C, b, h, chunk * 64 + (2 - t) * 16, lane);
            SCHED_FENCE();
            lru_step<2, 0, 0>(C, cst, xt, b, h, chunk, t, lane, cf, af, hfl);
            SCHED_FENCE();
            lru_step<2, 1, 0>(C, cst, xt + XT_TILE, b, h, chunk, 3 - t, lane, cb, ab, hfl);
        }
#pragma unroll 1
        for (int t = 2; t < 4; ++t) {
            asm volatile("" : "+s"(co));
            const LAS unsigned char* cst = cst_ + co;
            lru_stx(x0, lane, xt); lru_stx(x1, lane, xt + XT_TILE);
            lru_ldx(x0, C, b, h, chunk * 64 + 48, lane); lru_ldx(x1, C, b, h, chunk * 64, lane);
            SCHED_FENCE();
            lru_step<2, 0, 1>(C, cst, xt, b, h, chunk, t, lane, cf, af, hfl);
            SCHED_FENCE();
            lru_step<2, 1, 1>(C, cst, xt + XT_TILE, b, h, chunk, 3 - t, lane, cb, ab, hfl);
        }
    }
}
template <int PASS>
__device__ __forceinline__ void lru_phase(const LruCtx& C, LAS unsigned char* lds, int wave, int lane, int G, int bx) {
    const int h = bx & 15, jblk = bx >> 4, nblk = G >> 4;
    for (int combo = jblk * NWAVES + wave; combo < 256; combo += nblk * NWAVES) lru_unit<PASS>(C, combo >> 5, h, combo & 31, lane, lds, lds + L_HF + wave * L_HF_WAVE, PASS == 1 ? lds + L_HF + wave * L_HF_WAVE : lds + L_XT2 + wave * L_XT2_WAVE);
}

struct AttnCtx { const bf16_t* q; const bf16_t* k; const bf16_t* vT; const LAS float* rpb; bf16_t* y; float* ssB; };
__device__ __forceinline__ void attn_unit(const AttnCtx& C, int unit, int lane) {
    const int j = unit & 3, h = (unit >> 2) & 15, r = (unit >> 6) & 31, b = unit >> 11;
    const int fr = lane & 15, fq = lane >> 4;
    const int rs = min(max(r - 4, 0), 24), kc0 = min(max(16 * j - 8, 0), 32);
    const int qcol = 16 * j + fr, cs = min(max(qcol - 8, 0), 48);
    const size_t tq = (size_t)b * SEQ + r * 64 + qcol;
    const bf16x8 q0 = gld<bf16x8>(C.q + tq * LW + h * 64 + 8 * fq), q1 = gld<bf16x8>(C.q + tq * LW + h * 64 + 32 + 8 * fq);
    const bf16_t* kbase = C.k + (((size_t)(b * 16 + h) * 2) * SEQ + rs * 64 + kc0 + 8 * (fr >> 2) + (fr & 3)) * 32 + 8 * fq;
    const LAS float* bias_base = C.rpb + (h * 15 + (rs - r + 7)) * 32;
    float sv[8][8];
    float mx = -INFINITY;
    f32x4 o[4];
    {
        bf16x8 kf[8][2][2];
#pragma unroll
        for (int rr = 0; rr < 8; ++rr)
#pragma unroll
            for (int p = 0; p < 2; ++p) { const bf16_t* kp = kbase + (size_t)(rr * 64 + 4 * p) * 32; kf[rr][p][0] = gld<bf16x8>(kp); kf[rr][p][1] = gld<bf16x8>(kp + (size_t)SEQ * 32); }
        SCHED_FENCE();
#pragma unroll
        for (int rr = 0; rr < 8; ++rr) {
#pragma unroll
            for (int p = 0; p < 2; ++p) {
                f32x4 acc = (f32x4){0.f, 0.f, 0.f, 0.f};
                acc = MFMA16(kf[rr][p][0], q0, acc); acc = MFMA16(kf[rr][p][1], q1, acc);
#pragma unroll
                for (int e = 0; e < 4; ++e) {
                    const int kcol = kc0 + 8 * fq + 4 * p + e;
                    const bool valid = (kcol >= cs) && (kcol < cs + 16);
                    const int bi = min(max(kcol - qcol + 15, 0), 30);
                    const float bz = bias_base[rr * 32 + bi];
                    const float v = (acc[e] + bz) + (valid ? 0.0f : -INFINITY);
                    sv[rr][4 * p + e] = v; mx = fmaxf(mx, v);
                }
            }
        }
        SCHED_FENCE();
    }
    {
        bf16x8 vf[8][4];
        const bf16_t* vbase = C.vT + ((((size_t)((b * 16 + h) * 32 + rs)) * 8 + (kc0 >> 3) + fq) * 64 + fr) * 8;
#pragma unroll
        for (int rr = 0; rr < 8; ++rr)
#pragma unroll
            for (int d = 0; d < 4; ++d) vf[rr][d] = gld<bf16x8>(vbase + (size_t)rr * (8 * 64 * 8) + d * (16 * 8));
        SCHED_FENCE();
        mx = fmaxf(mx, __shfl_xor(mx, 16)); mx = fmaxf(mx, __shfl_xor(mx, 32));
        float sum_ = 0.f;
#pragma unroll
        for (int rr = 0; rr < 8; ++rr)
#pragma unroll
            for (int i = 0; i < 8; ++i) { const float p = __builtin_amdgcn_exp2f((sv[rr][i] - mx) * 1.44269504089f); sv[rr][i] = p; sum_ += p; }
        sum_ += __shfl_xor(sum_, 16); sum_ += __shfl_xor(sum_, 32);
        sv[0][0] = sv[0][0];
        SCHED_FENCE();
#pragma unroll
        for (int d = 0; d < 4; ++d) o[d] = (f32x4){0.f, 0.f, 0.f, 0.f};
#pragma unroll
        for (int rr = 0; rr < 8; ++rr) {
            const bf16x8 pf = mk8(sv[rr][0], sv[rr][1], sv[rr][2], sv[rr][3], sv[rr][4], sv[rr][5], sv[rr][6], sv[rr][7]);
#pragma unroll
            for (int d = 0; d < 4; ++d) o[d] = MFMA16(vf[rr][d], pf, o[d]);
        }
        mx = sum_;
    }
    const float sum = mx;
    const float inv = __builtin_amdgcn_rcpf(sum); float ssq = 0.f;
#pragma unroll
    for (int d = 0; d < 4; ++d) {
        const f32x4 ov = o[d] * inv; ssq += (ov[0] * ov[0] + ov[1] * ov[1]) + (ov[2] * ov[2] + ov[3] * ov[3]);
        u32x2 w; w.x = pk2(ov[0], ov[1]); w.y = pk2(ov[2], ov[3]);
        gst<u32x2>(C.y + tq * D + LW + h * 64 + 16 * d + 4 * fq, w);
    }
    ssq += __shfl_xor(ssq, 16); ssq += __shfl_xor(ssq, 32);
    if (fq == 0) gatomic_add(C.ssB + tq, ssq);
}

__global__ void __launch_bounds__(NWAVES * 64, 2) mk_fwd(Args args) {
    extern __shared__ __attribute__((aligned(16))) unsigned char lds_raw[];
    LAS unsigned char* lds = (LAS unsigned char*)lds_raw;
    KArgs ka0 = (KArgs)__builtin_amdgcn_kernarg_segment_ptr();
    const int ph_lo = ka0->ph_lo, ph_hi = ka0->ph_hi, coop = ka0->coop;
    const int wave0 = __builtin_amdgcn_readfirstlane((int)(threadIdx.x >> 6));
    if (threadIdx.x < 2) ((volatile LAS unsigned*)(lds + L_BARST))[threadIdx.x] = 0u;
    __syncthreads();
    XcdBarrier bar; bar.bar = (unsigned*)(ka0->ws + WS_BAR); bar.x = 0; bar.st = (volatile LAS unsigned*)(lds + L_BARST);
    if (coop == 1) bar = xcd_barrier_post((unsigned*)(ka0->ws + WS_BAR), (volatile LAS unsigned*)(lds + L_BARST), (int)threadIdx.x);
    for (int ph = ph_lo; ph < ph_hi; ++ph) {
        KArgs ka = ka0; asm volatile("" : "+s"(ka));
        int lane_ = (int)__builtin_amdgcn_mbcnt_hi(~0u, __builtin_amdgcn_mbcnt_lo(~0u, 0u)); asm volatile("" : "+v"(lane_));
        int tid = wave0 * 64 + lane_;
        unsigned char* ws = ka->ws; asm volatile("" : "+s"(ws));
        int wave = wave0, bx = (int)blockIdx.x; asm volatile("" : "+s"(wave), "+s"(bx));
        const int lane = lane_ & 63;
        float* SS = (float*)(ws + WS_SS);
        float *ssx = SS, *ssh1 = SS + 16384, *ssA = SS + 2 * 16384, *ssB = SS + 3 * 16384, *ssh2 = SS + 4 * 16384, *ssh3 = SS + 5 * 16384;
        bf16_t* HB = (bf16_t*)(ws + WS_HB); bf16_t* Y = (bf16_t*)(ws + WS_Y); bf16_t* ACT = (bf16_t*)(ws + WS_ACT);
        const int G = gridDim.x, gw = bx * NWAVES + wave, NGW = G * NWAVES;
        if (ph == 0) {
            p0_prologue(ka, ws, lds, wave, lane, bx);
        } else if (ph == 1 || ph == 8) {
            const bool f1 = (ph == 1);
            pg8::Gemm g{HB, (const bf16_t*)(ws + (f1 ? WS_W1I : WS_W2I)), M, 2 * FF, D}; pg8::StaticOrder S; S.init(M, 2 * FF, G, bx);
            pg8::EpiSwiGLU E{f1 ? ssx : ssh2, ACT, FF};
#if !defined(NO_GEMM) && !defined(NO_G1)
            pg8::gemm_phase<pg8::EpiSwiGLU, pg8::StaticOrder, true, true>(lds, g, S, E, tid);
#endif
        } else if (ph == 2 || ph == 9) {
            const bf16_t* Bt = (const bf16_t*)(ws + (ph == 2 ? WS_W1O : WS_W2O));
            pg8::Gemm g{ACT, Bt, M, D, FF}; pg8::StaticOrder S; S.init(M, D, G, bx);
            pg8::EpiResid<false> E{ph == 2 ? ka->in[0] : (const float*)nullptr, HB, ph == 2 ? ssh1 : ssh3, 0.5f, nullptr, nullptr};
            pg8::gemm_phase<pg8::EpiResid<false>, pg8::StaticOrder, true, true>(lds, g, S, E, tid);
        } else if (ph == 7) {
            pg8::Gemm g{Y, (const bf16_t*)(ws + WS_WMO), M, D, D}; pg8::StaticOrder S; S.init(M, D, G, bx);
            pg8::EpiResid<true> E{(const float*)nullptr, HB, ssh2, 1.0f, ssA, ssB};
            pg8::gemm_phase<pg8::EpiResid<true>, pg8::StaticOrder, true, true>(lds, g, S, E, tid);
        } else if (ph == 3) {
            { pg8::Gemm g{HB, (const bf16_t*)(ws + WS_WMI), M, 4096, D}; pg8::StaticOrder S; S.init(M, 4096, G, bx);
              pg8::EpiProj E{ssh1, ACT};
#if !defined(NO_GEMM) && !defined(NO_G3)
              pg8::gemm_phase<pg8::EpiProj, pg8::StaticOrder, true, true>(lds, g, S, E, tid);
#endif
            }
            { pg8::Gemm g{(const bf16_t*)(ws + WS_WMI) + (size_t)4096 * D, HB, 1024, M, D}; pg8::StaticOrder S; S.init(1024, M, G, bx);
              pg8::EpiVT E{ssh1, ACT + 4 * (size_t)M * LW};
#if !defined(NO_GEMM) && !defined(NO_G4)
              pg8::gemm_phase<pg8::EpiVT, pg8::StaticOrder, true, true>(lds, g, S, E, tid);
#endif
            }
        } else if (ph == 4 || ph == 5) {
            const size_t SEG = (size_t)M * LW;
            LruCtx C{ACT, ACT + SEG, ka->in[6], ka->in[7], (const u32x4*)(ws + WS_GWP), ka->in[9], (const float*)(ws + WS_SP8), (float*)(ws + WS_AGG), (float*)(ws + WS_AGG + 2 * MiB), Y, ssA};
            lru_stage_consts(C, lds, bx & 15, tid);
            if (ph == 4) {
                { LAS float* tab = (LAS float*)(lds + L_RPB); const float* rpb = ka->in[11];
                  for (int i = tid; i < 16 * 15 * 32; i += NWAVES * 64) { const int rw = i >> 5, c = i & 31; tab[i] = c < 31 ? gld<float>(rpb + rw * 31 + c) : 0.f; } }
                __syncthreads();
                for (int step = 0; step < 2; ++step) {
                    const bool do_lru = (step == 0) == (wave < 4);
                    int lane_s = lane; asm volatile("" : "+v"(lane_s));
                    if (do_lru) { lru_phase<1>(C, lds, wave, lane_s, G, bx); }
                    else {
                        AttnCtx A{ACT + 2 * SEG, ACT + 3 * SEG, ACT + 4 * SEG, (const LAS float*)(lds + L_RPB), Y, ssB};
                        if (G == 256) {
                            for (int i = 0; i < 8; ++i) attn_unit(A, ((bx & 7) << 11) | (i * 256 + (bx >> 3) * 8 + wave), lane_s);
                        } else { for (int u = gw; u < 16384; u += NGW) attn_unit(A, u, lane_s); }
                    }
                    asm volatile("" : "+v"(tid));
                }
            } else {
                __syncthreads();
                lru_phase<2>(C, lds, wave, lane, G, bx);
            }
            __syncthreads();
        } else if (ph == 6) {
        } else {
            const float* gF = ka->in[18];
            const f32x4* gr = (const f32x4*)gF + lane;
            for (int m0 = gw; m0 < M; m0 += 4 * NGW) {
                int mr[4]; float ss[4]; u32x2 r[4][8];
#pragma unroll
                for (int q = 0; q < 4; ++q) { mr[q] = (m0 + q * NGW < M) ? m0 + q * NGW : m0; ss[q] = gld<float>(ssh3 + mr[q]); }
#pragma unroll
                for (int q = 0; q < 4; ++q)
#pragma unroll
                    for (int j = 0; j < 8; ++j) r[q][j] = gld_nt<u32x2>((const u32x2*)(HB + (size_t)mr[q] * D) + lane + 64 * j);
#pragma unroll
                for (int j = 0; j < 8; ++j) { const f32x4 g = gld<f32x4>(gr + 64 * j);
#pragma unroll
                    for (int q = 0; q < 4; ++q) if (q == 0 || mr[q] != m0) {
                        const float rs = pg8::rstd_of(ss[q], 1.0f / 2048.0f);
                        gst_nt<f32x4>((f32x4*)(ka->out + (size_t)mr[q] * D) + lane + 64 * j, (f32x4){bf_lo(r[q][j].x), bf_hi(r[q][j].x), bf_lo(r[q][j].y), bf_hi(r[q][j].y)} * g * rs); }
                }
            }
        }
        if (ph + 1 < ph_hi && ph != 6) {
            if (coop == 1) xcd_barrier(bar, tid);
            else if (coop == 2) cg::this_grid().sync();
        }
    }
}

extern "C" void kernel_launch(void* const* d_in, const int* in_sizes, int n_in, void* d_out, int out_size, void* d_ws, size_t ws_size, hipStream_t stream) {
    static int grid = 0;
    if (grid == 0) {
        if (n_in != 19 || out_size != M * D || ws_size < WS_END) { fprintf(stderr, "kernel_launch: unexpected shapes (n_in %d, out %d, ws %zu)\n", n_in, out_size, ws_size); grid = -1; return; }
        int dev = 0, cus = 0, per_cu = 0;
        hipGetDevice(&dev); hipDeviceGetAttribute(&cus, hipDeviceAttributeMultiprocessorCount, dev);
        if (hipFuncSetAttribute((const void*)mk_fwd, hipFuncAttributeMaxDynamicSharedMemorySize, LDS_BYTES) != hipSuccess) { fprintf(stderr, "kernel_launch: hipFuncSetAttribute failed\n"); grid = -1; return; }
        if (hipOccupancyMaxActiveBlocksPerMultiprocessor(&per_cu, (const void*)mk_fwd, NWAVES * 64, LDS_BYTES) != hipSuccess || per_cu < 1) { fprintf(stderr, "kernel_launch: occupancy query says %d\n", per_cu); per_cu = 1; }
        (void)hipGetLastError();
        grid = cus * 1;
        if (grid != 256) fprintf(stderr, "kernel_launch: note: grid %d\n", grid);
    }
    if (grid < 0) return;
    Args a{};
    for (int i = 0; i < 19; ++i) a.in[i] = (const float*)d_in[i];
    a.out = (float*)d_out; a.ws = (unsigned char*)d_ws;
#if MK_COOP
    if (hipMemsetAsync((char*)d_ws + WS_BAR, 0, 16384, stream) != hipSuccess) { fprintf(stderr, "kernel_launch: memset of the barrier words failed\n"); return; }
    a.ph_lo = 0; a.ph_hi = N_PHASES; a.coop = 1;
    void* kargs[] = {&a};
    hipError_t e = hipLaunchCooperativeKernel((const void*)mk_fwd, dim3(grid), dim3(NWAVES * 64), kargs, LDS_BYTES, stream);
    if (e != hipSuccess) fprintf(stderr, "kernel_launch: cooperative launch failed: %s\n", hipGetErrorString(e));
#else
    for (int ph = 0; ph < N_PHASES; ++ph) {
        a.ph_lo = ph; a.ph_hi = ph + 1; a.coop = 0;
        hipLaunchKernelGGL(mk_fwd, dim3(grid), dim3(NWAVES * 64), LDS_BYTES, stream, a);
    }
#endif
}
```

```cpp
#include <hip/hip_runtime.h>
#include <hip/hip_cooperative_groups.h>
#include <cstdio>
#include <cstdint>
#include <cmath>
namespace cg = cooperative_groups;
namespace pg8 {
#define PG8_LAS __attribute__((address_space(3)))
typedef unsigned short bf16_t;
typedef short bf16x8 __attribute__((ext_vector_type(8)));
typedef float f32x4 __attribute__((ext_vector_type(4)));
typedef unsigned u32x4 __attribute__((ext_vector_type(4)));
constexpr int BM = 256, BK = 64, HALF = 128, HTB = HALF * BK * 2  , STAGE_BYTES = 8 * HTB, NXCD = 8, WGM = 8;

__host__ __device__ __forceinline__ int lds_byte(int r, int c) { const int st = (r >> 4) * 2 + (c >> 5), rr = r & 15, cc = c & 31, ob = rr * 64 + cc * 2; return st * 1024 + (ob ^ (((ob >> 9) & 1) << 5)); }
__host__ __device__ __forceinline__ void stage_rc(int b, int& R, int& C) { const int st = b / 1024, sb = b % 1024, swz = sb ^ (((sb >> 9) & 1) << 5); R = (st >> 1) * 16 + swz / 64; C = (st & 1) * 32 + (swz % 64) / 2; }
__host__ __device__ __forceinline__ int perm32(int rho) { const int n = rho >> 4, i = rho & 15; return 8 * (i >> 2) + 4 * n + (i & 3); }

struct Unit { int pm, pn; };
struct Gemm { const bf16_t* A; const bf16_t* Bt; int M, N, K; };

struct StaticOrder {
    int nM, nN, nwg, G, c;
    __host__ __device__ void init(int M, int N, int G_, int c_) { nM = M / BM; nN = N / BM; nwg = nM * nN; G = G_; c = c_; }
    __host__ __device__ bool next(int i, Unit& u) const {
        const long L = (long)i * G + c; if (L >= nwg) return false;
        int wgid = (int)L; { const int q = nwg / NXCD, r = nwg % NXCD, xcd = wgid % NXCD, off = wgid / NXCD; wgid = (xcd < r ? xcd * (q + 1) : r * (q + 1) + (xcd - r) * q) + off; }
        const int nig = WGM * nN, gid = wgid / nig, fm = gid * WGM, gsz = (nM - fm) < WGM ? (nM - fm) : WGM;
        u.pm = fm + ((wgid % nig) % gsz); u.pn = (wgid % nig) / gsz; return true;
    }
    __device__ __forceinline__ void a_ready(const Unit&) const {}
    __device__ __forceinline__ void done(const Unit&) const {}
};

__device__ __forceinline__ unsigned cvt_pk_bf16(float lo, float hi) { unsigned r; asm volatile("v_cvt_pk_bf16_f32 %0, %1, %2" : "=v"(r) : "v"(lo), "v"(hi)); return r; }
typedef float f32x2 __attribute__((ext_vector_type(2)));
#define GAS __attribute__((address_space(1)))
template <class T> __device__ __forceinline__ T gld(const void* p) { return *(const GAS T*)p; }
template <class T> __device__ __forceinline__ void gst(void* p, T v) { *(GAS T*)p = v; }
template <class T> __device__ __forceinline__ void gst_nt(void* p, T v) { __builtin_nontemporal_store(v, (GAS T*)p); }
template <class T> __device__ __forceinline__ T gld_nt(const void* p) { return __builtin_nontemporal_load((const GAS T*)p); }
__device__ __forceinline__ void gatomic_add(float* p, float v) { (void)__hip_atomic_fetch_add((GAS float*)p, v, __ATOMIC_RELAXED, __HIP_MEMORY_SCOPE_AGENT); }
typedef unsigned u32x2 __attribute__((ext_vector_type(2)));
constexpr float RMS_EPS = 1e-6f;
__device__ __forceinline__ float rstd_of(float ss, float inv_n) { return __builtin_amdgcn_rsqf(ss * inv_n + RMS_EPS); }
__device__ __forceinline__ float silu_f(float g) { return g * __builtin_amdgcn_rcpf(1.0f + __expf(-g)); }

struct EpiSwiGLU {
    static constexpr bool PERM = true, AFTER_DRAIN = false, HAS_MID = false;
    const float* ss; bf16_t* O; int ldo;
    __device__ __forceinline__ void mid(f32x4 (&)[2][2][4][2], const Unit&, int, int) const {}
    __device__ __forceinline__ void operator()(const f32x4 (&acc)[2][2][4][2], const Unit& u, int wr, int wc, int fr, int fq) const {
        const int row0 = u.pm * BM + wr * 64 + fr; const int col0 = u.pn * HALF + wc * 32 + 8 * fq;
        float rsv[2][4];
#pragma unroll
        for (int ai = 0; ai < 2; ++ai)
#pragma unroll
            for (int m = 0; m < 4; ++m) rsv[ai][m] = gld<float>(ss + row0 + ai * HALF + m * 16);
        __builtin_amdgcn_sched_barrier(0);
#pragma unroll
        for (int ai = 0; ai < 2; ++ai)
#pragma unroll
            for (int m = 0; m < 4; ++m) {
                const int row = row0 + ai * HALF + m * 16;
                const float rs = rstd_of(rsv[ai][m], 1.0f / 2048.0f);
                float v[8];
                const float cneg = rs * -1.44269504089f, rs2 = rs * rs;
#pragma unroll
                for (int n = 0; n < 2; ++n)
#pragma unroll
                    for (int hh = 0; hh < 2; ++hh) {
                        const f32x2 g = (f32x2){acc[ai][0][m][n][2 * hh], acc[ai][0][m][n][2 * hh + 1]}, up = (f32x2){acc[ai][1][m][n][2 * hh], acc[ai][1][m][n][2 * hh + 1]};
                        const f32x2 t = g * cneg;
                        f32x2 d; d.x = __builtin_amdgcn_exp2f(t.x); d.y = __builtin_amdgcn_exp2f(t.y); d = d + 1.0f;
                        f32x2 r; r.x = __builtin_amdgcn_rcpf(d.x); r.y = __builtin_amdgcn_rcpf(d.y);
                        const f32x2 o = (g * up) * (r * rs2);
                        v[n * 4 + 2 * hh] = o.x; v[n * 4 + 2 * hh + 1] = o.y;
                    }
                u32x4 w; w.x = cvt_pk_bf16(v[0], v[1]); w.y = cvt_pk_bf16(v[2], v[3]); w.z = cvt_pk_bf16(v[4], v[5]); w.w = cvt_pk_bf16(v[6], v[7]);
                gst<u32x4>(O + (size_t)row * ldo + col0, w);
            }
    }
};

struct EpiProj {
    static constexpr bool PERM = true, AFTER_DRAIN = false, HAS_MID = false;
    const float* ss; bf16_t* base;
    __device__ __forceinline__ void mid(f32x4 (&)[2][2][4][2], const Unit&, int, int) const {}
    __device__ __forceinline__ void operator()(const f32x4 (&acc)[2][2][4][2], const Unit& u, int wr, int wc, int fr, int fq) const {
        const int seg = u.pn >> 2; const int colt = (u.pn & 3) * BM + wc * 32 + 8 * fq;
        const int row0 = u.pm * BM + wr * 64 + fr;
        const float qs = (seg == 2) ? 0.125f * 1.44269504089f : 1.0f;
        bf16_t* op = base + (size_t)seg * ((size_t)16384 * 1024) + (size_t)row0 * 1024 + colt;
        float rsv[2][4];
#pragma unroll
        for (int ai = 0; ai < 2; ++ai)
#pragma unroll
            for (int m = 0; m < 4; ++m) rsv[ai][m] = gld<float>(ss + row0 + ai * HALF + m * 16);
        __builtin_amdgcn_sched_barrier(0);
        const int kb_b = (u.pm * BM) >> 11, kb_s0 = row0 & 2047;
#pragma unroll
        for (int ai = 0; ai < 2; ++ai)
#pragma unroll
            for (int m = 0; m < 4; ++m) {
                const float rs = rstd_of(rsv[ai][m], 1.0f / 2048.0f) * qs;
#pragma unroll
                for (int bj = 0; bj < 2; ++bj) {
                    const f32x4 v0 = acc[ai][bj][m][0] * rs, v1 = acc[ai][bj][m][1] * rs;
                    u32x4 w; w.x = cvt_pk_bf16(v0[0], v0[1]); w.y = cvt_pk_bf16(v0[2], v0[3]); w.z = cvt_pk_bf16(v1[0], v1[1]); w.w = cvt_pk_bf16(v1[2], v1[3]);
                    if (seg == 3) { const int col = colt + bj * HALF, s = kb_s0 + ai * HALF + m * 16;
                        gst<u32x4>(base + (size_t)3 * ((size_t)16384 * 1024) + ((((size_t)(kb_b * 16 + (col >> 6))) * 2 + ((col >> 5) & 1)) * 2048 + s) * 32 + (col & 31), w); }
                    else gst<u32x4>(op + (size_t)(ai * HALF + m * 16) * 1024 + bj * HALF, w);
                }
                asm volatile("" ::: "memory");
            }
    }
};
struct EpiVT {
    static constexpr bool PERM = true, AFTER_DRAIN = false, HAS_MID = false;
    const float* ss; bf16_t* vT;
    __device__ __forceinline__ void mid(f32x4 (&)[2][2][4][2], const Unit&, int, int) const {}
    __device__ __forceinline__ void operator()(const f32x4 (&acc)[2][2][4][2], const Unit& u, int wr, int wc, int fr, int fq) const {
        const int tok0 = u.pn * BM + wc * 32 + 8 * fq;
        const int b = tok0 >> 11, s0 = tok0 & 2047;
#pragma unroll
        for (int bj = 0; bj < 2; ++bj) {
            const f32x4 s_lo = gld<f32x4>(ss + tok0 + bj * HALF), s_hi = gld<f32x4>(ss + tok0 + bj * HALF + 4);
            float rs[8];
#pragma unroll
            for (int e = 0; e < 4; ++e) { rs[e] = rstd_of(s_lo[e], 1.0f / 2048.0f); rs[4 + e] = rstd_of(s_hi[e], 1.0f / 2048.0f); }
#pragma unroll
            for (int ai = 0; ai < 2; ++ai)
#pragma unroll
                for (int m = 0; m < 4; ++m) {
                    const f32x4 v0 = acc[ai][bj][m][0], v1 = acc[ai][bj][m][1];
                    u32x4 w; w.x = cvt_pk_bf16(v0[0] * rs[0], v0[1] * rs[1]); w.y = cvt_pk_bf16(v0[2] * rs[2], v0[3] * rs[3]); w.z = cvt_pk_bf16(v1[0] * rs[4], v1[1] * rs[5]); w.w = cvt_pk_bf16(v1[2] * rs[6], v1[3] * rs[7]);
                    { const int hh = 4 * u.pm + wr + 2 * ai, dd = 16 * m + fr, s = s0 + bj * HALF;
                      gst<u32x4>(vT + ((((size_t)((b * 16 + hh) * 32 + (s >> 6))) * 8 + ((s >> 3) & 7)) * 64 + dd) * 8, w); }
                }
            asm volatile("" ::: "memory");
        }
    }
};

template <bool MIX> struct EpiResid {
    static constexpr bool PERM = true, AFTER_DRAIN = false, HAS_MID = MIX;
    const float* resid_f; bf16_t* hb; float* ss_out; float alpha; const float* ssA; const float* ssB;
    __device__ __forceinline__ void mid(f32x4 (&acc)[2][2][4][2], const Unit& u, int wr, int fr) const {
        if constexpr (MIX) {
            const int row0 = u.pm * BM + wr * 64 + fr;
            float sa[2][4], sb[2][4];
#pragma unroll
            for (int ai = 0; ai < 2; ++ai)
#pragma unroll
                for (int m = 0; m < 4; ++m) { sa[ai][m] = gld<float>(ssA + row0 + ai * HALF + m * 16); sb[ai][m] = gld<float>(ssB + row0 + ai * HALF + m * 16); }
#pragma unroll
            for (int ai = 0; ai < 2; ++ai)
#pragma unroll
                for (int m = 0; m < 4; ++m) {
                    const float f = rstd_of(sa[ai][m], 1.0f / 1024.0f) * __builtin_amdgcn_rcpf(rstd_of(sb[ai][m], 1.0f / 1024.0f));
#pragma unroll
                    for (int bj = 0; bj < 2; ++bj)
#pragma unroll
                        for (int n = 0; n < 2; ++n) acc[ai][bj][m][n] = acc[ai][bj][m][n] * f;
                }
        }
    }
    __device__ __forceinline__ void operator()(const f32x4 (&acc)[2][2][4][2], const Unit& u, int wr, int wc, int fr, int fq) const {
        const int row0 = u.pm * BM + wr * 64 + fr; const int col0 = u.pn * BM + wc * 32 + 8 * fq;
#pragma unroll
        for (int ai = 0; ai < 2; ++ai) {
            float sbv[4] = {0.f, 0.f, 0.f, 0.f};
            if constexpr (MIX) {
#pragma unroll
                for (int m = 0; m < 4; ++m) sbv[m] = gld<float>(ssB + row0 + ai * HALF + m * 16);
            }
            f32x4 pre[4][2][2];
            if (resid_f) {
#pragma unroll
                for (int m = 0; m < 4; ++m) { const size_t off = (size_t)(row0 + ai * HALF + m * 16) * 2048 + col0;
#pragma unroll
                    for (int bj = 0; bj < 2; ++bj)
#pragma unroll
                        for (int n = 0; n < 2; ++n) pre[m][bj][n] = gld_nt<f32x4>(resid_f + off + bj * HALF + n * 4); }
            } else {
                u32x4 raw[4][2];
#pragma unroll
                for (int m = 0; m < 4; ++m) { const size_t off = (size_t)(row0 + ai * HALF + m * 16) * 2048 + col0;
#pragma unroll
                    for (int bj = 0; bj < 2; ++bj) raw[m][bj] = gld<u32x4>(hb + off + bj * HALF); }
                __builtin_amdgcn_sched_barrier(0);
#pragma unroll
                for (int m = 0; m < 4; ++m)
#pragma unroll
                    for (int bj = 0; bj < 2; ++bj) { const u32x4 r = raw[m][bj];
                        pre[m][bj][0] = (f32x4){__uint_as_float(r.x << 16), __uint_as_float(r.x & 0xffff0000u), __uint_as_float(r.y << 16), __uint_as_float(r.y & 0xffff0000u)};
                        pre[m][bj][1] = (f32x4){__uint_as_float(r.z << 16), __uint_as_float(r.z & 0xffff0000u), __uint_as_float(r.w << 16), __uint_as_float(r.w & 0xffff0000u)}; }
            }
            __builtin_amdgcn_sched_barrier(0);
#pragma unroll
            for (int m = 0; m < 4; ++m) {
                const int row = row0 + ai * HALF + m * 16;
                const size_t off = (size_t)row * 2048 + col0;
                float s2 = 0.f;
                const float sc = MIX ? rstd_of(sbv[m], 1.0f / 1024.0f) : alpha;
#pragma unroll
                for (int bj = 0; bj < 2; ++bj) {
                    const f32x4 o0 = pre[m][bj][0] + acc[ai][bj][m][0] * sc, o1 = pre[m][bj][1] + acc[ai][bj][m][1] * sc;
                    s2 += ((o0[0] * o0[0] + o0[1] * o0[1]) + (o0[2] * o0[2] + o0[3] * o0[3])) + ((o1[0] * o1[0] + o1[1] * o1[1]) + (o1[2] * o1[2] + o1[3] * o1[3]));
                    u32x4 w; w.x = cvt_pk_bf16(o0[0], o0[1]); w.y = cvt_pk_bf16(o0[2], o0[3]); w.z = cvt_pk_bf16(o1[0], o1[1]); w.w = cvt_pk_bf16(o1[2], o1[3]);
                    gst<u32x4>(hb + off + bj * HALF, w);
                }
                s2 += __shfl_xor(s2, 16); s2 += __shfl_xor(s2, 32);
                if (fq == 0) gatomic_add(ss_out + row, s2);
            }
            asm volatile("" ::: "memory");
        }
    }
};
template <class Epi, class Sched, bool ALIGN_EPI = false, bool SP2 = false>
__device__ __forceinline__ void gemm_phase(PG8_LAS unsigned char* lds, const Gemm g, const Sched& S, const Epi& E, int tid_in) {
    int tid_ = tid_in; asm volatile("" : "+v"(tid_));
    const int tid = tid_, wid = __builtin_amdgcn_readfirstlane(tid >> 6), lane = tid & 63, wr = wid >> 2, wc = wid & 3, fr = lane & 15, fq = lane >> 4;
    const int K = g.K, nt = K / BK;
    unsigned voffA[2], voffB[2];
#pragma unroll
    for (int i = 0; i < 2; ++i) { int R, C; stage_rc(tid * 16 + i * 8192, R, C); const int Rb = Epi::PERM ? ((R & ~31) + perm32(R & 31)) : R;
        voffA[i] = (unsigned)(R * K + C) * 2u; voffB[i] = (unsigned)(Rb * K + C) * 2u; }
    const size_t kstep = (size_t)(BK * 2);
    const size_t hstep = (size_t)HALF * K * 2;
    const size_t tstep = 2 * hstep;
    const unsigned ldsw = (unsigned)wid * 1024u;
    const int aoff = lds_byte(wr * 64 + fr, fq * 8), boff = lds_byte(wc * 32 + fr, fq * 8);
#define PG8_SA(b, h) (((b) * 2 + (h)) * HTB)
#define PG8_SB(b, h) ((4 + (b) * 2 + (h)) * HTB)
#define PG8_STAGE(bufoff, gbase, voff) do { _Pragma("unroll") for (int _i = 0; _i < 2; ++_i) \
        __builtin_amdgcn_global_load_lds((const unsigned*)((const char*)(gbase) + (voff)[_i]), (PG8_LAS unsigned*)(lds + (bufoff) + ldsw + _i * 8192), 16, 0, 0); } while (0)
#define PG8_LDA(dst, b, h) do { _Pragma("unroll") for (int m = 0; m < 4; ++m) _Pragma("unroll") for (int k = 0; k < 2; ++k) dst[m][k] = *(const PG8_LAS bf16x8*)(lds + PG8_SA(b, h) + aoff + m * 2048 + k * 1024); } while (0)
#define PG8_LDB(dst, b, h) do { _Pragma("unroll") for (int n = 0; n < 2; ++n) _Pragma("unroll") for (int k = 0; k < 2; ++k) dst[n][k] = *(const PG8_LAS bf16x8*)(lds + PG8_SB(b, h) + boff + n * 2048 + k * 1024); } while (0)
#define PG8_MMA(ai, bj, At, Bt) do { __builtin_amdgcn_s_setprio(1); _Pragma("unroll") for (int m = 0; m < 4; ++m) _Pragma("unroll") for (int n = 0; n < 2; ++n) _Pragma("unroll") for (int k = 0; k < 2; ++k) \
        acc[ai][bj][m][n] = __builtin_amdgcn_mfma_f32_16x16x32_bf16(Bt[n][k], At[m][k], acc[ai][bj][m][n], 0, 0, 0); __builtin_amdgcn_s_setprio(0); } while (0)
#define PG8_WAIT_V(n) asm volatile("s_waitcnt vmcnt(" #n ")" ::: "memory")
#define PG8_WAIT_L(n) asm volatile("s_waitcnt lgkmcnt(" #n ")" ::: "memory")
#define PG8_BAR __builtin_amdgcn_s_barrier()
#define PG8_SCHED __builtin_amdgcn_sched_barrier(0)
    Unit cur, nxt; int ui = 0;
    if (!S.next(0, cur)) return;
    f32x4 acc[2][2][4][2];
#pragma unroll
    for (int a = 0; a < 2; ++a)
#pragma unroll
        for (int b = 0; b < 2; ++b)
#pragma unroll
            for (int m = 0; m < 4; ++m)
#pragma unroll
                for (int n = 0; n < 2; ++n) acc[a][b][m][n] = (f32x4){0.f, 0.f, 0.f, 0.f};
    bf16x8 At[4][2], B0[2][2], B1[2][2];
    const char* cA = (const char*)g.A + (size_t)cur.pm * tstep; const char* cB = (const char*)g.Bt + (size_t)cur.pn * tstep;
    S.a_ready(cur);
    if constexpr (SP2) {
        PG8_STAGE(PG8_SB(0, 0), cB, voffB); PG8_STAGE(PG8_SB(0, 1), cB + hstep, voffB); PG8_STAGE(PG8_SA(0, 0), cA, voffA); PG8_STAGE(PG8_SA(0, 1), cA + hstep, voffA);
        if (wr == 1) PG8_BAR;
        PG8_WAIT_V(2); PG8_BAR;
        PG8_STAGE(PG8_SB(1, 0), cB + kstep, voffB); PG8_STAGE(PG8_SA(1, 0), cA + kstep, voffA); PG8_STAGE(PG8_SB(1, 1), cB + hstep + kstep, voffB);
        PG8_WAIT_V(6); PG8_BAR;
    } else {
        PG8_STAGE(PG8_SB(0, 0), cB, voffB); PG8_STAGE(PG8_SA(0, 0), cA, voffA); PG8_STAGE(PG8_SB(0, 1), cB + hstep, voffB); PG8_STAGE(PG8_SA(0, 1), cA + hstep, voffA);
        if (wr == 1) PG8_BAR;
        PG8_WAIT_V(4); PG8_BAR;
        PG8_STAGE(PG8_SB(1, 0), cB + kstep, voffB); PG8_STAGE(PG8_SA(1, 0), cA + kstep, voffA); PG8_STAGE(PG8_SB(1, 1), cB + hstep + kstep, voffB);
        PG8_WAIT_V(6); PG8_BAR;
    }
    for (;;) {
        const bool has_next = S.next(ui + 1, nxt);
        const char* nA = has_next ? (const char*)g.A + (size_t)nxt.pm * tstep : cA; const char* nB = has_next ? (const char*)g.Bt + (size_t)nxt.pn * tstep : cB;
        constexpr int NHK = Epi::HAS_MID ? 2 : 1;
#pragma unroll
        for (int hk = 0; hk < NHK; ++hk) {
        if constexpr (Epi::HAS_MID) { if (hk == 1) E.mid(acc, cur, wr, fr); }
        const int t_beg = hk * (nt / NHK), t_end = (hk + 1) * (nt / NHK);
        for (int t = t_beg; t < t_end; t += 2) {
            const bool last = (t == nt - 2);
            const char* a1 = cA + (size_t)(t + 1) * kstep;
            const char* a2 = last ? nA : cA + (size_t)(t + 2) * kstep; const char* b2 = last ? nB : cB + (size_t)(t + 2) * kstep;
            const char* a3 = a2 + kstep; const char* b3 = b2 + kstep;
            if (last && has_next) S.a_ready(nxt);
            if constexpr (SP2) {
            PG8_LDB(B0, 0, 0); PG8_LDB(B1, 0, 1); PG8_SCHED; PG8_LDA(At, 0, 0); PG8_STAGE(PG8_SA(1, 1), a1 + hstep, voffA);
            PG8_WAIT_V(8); PG8_WAIT_L(0); PG8_BAR; PG8_MMA(0, 0, At, B0); PG8_MMA(0, 1, At, B1); PG8_BAR; PG8_SCHED;
            PG8_LDA(At, 0, 1); PG8_STAGE(PG8_SB(0, 0), b2, voffB); PG8_STAGE(PG8_SB(0, 1), b2 + hstep, voffB); PG8_STAGE(PG8_SA(0, 0), a2, voffA);
            PG8_WAIT_V(8); PG8_WAIT_L(0); PG8_BAR; PG8_MMA(1, 0, At, B0); PG8_MMA(1, 1, At, B1); PG8_BAR; PG8_SCHED;
            PG8_LDB(B0, 1, 0); PG8_LDB(B1, 1, 1); PG8_SCHED; PG8_LDA(At, 1, 0); PG8_STAGE(PG8_SA(0, 1), a2 + hstep, voffA);
            PG8_WAIT_V(8); PG8_WAIT_L(0); PG8_BAR; PG8_MMA(0, 0, At, B0); PG8_MMA(0, 1, At, B1); PG8_BAR; PG8_SCHED;
            PG8_LDA(At, 1, 1); PG8_STAGE(PG8_SB(1, 0), b3, voffB); PG8_STAGE(PG8_SB(1, 1), b3 + hstep, voffB); PG8_STAGE(PG8_SA(1, 0), a3, voffA);
            PG8_WAIT_V(8); PG8_WAIT_L(0); PG8_BAR; PG8_MMA(1, 0, At, B0); PG8_MMA(1, 1, At, B1); PG8_BAR; PG8_SCHED;
            } else {
            PG8_LDB(B0, 0, 0); PG8_SCHED; PG8_LDA(At, 0, 0); PG8_STAGE(PG8_SA(1, 1), a1 + hstep, voffA);
            PG8_WAIT_L(8); PG8_BAR; PG8_WAIT_L(0); PG8_MMA(0, 0, At, B0); PG8_BAR; PG8_SCHED;
            PG8_LDB(B1, 0, 1); PG8_STAGE(PG8_SB(0, 0), b2, voffB);
            PG8_BAR; PG8_WAIT_L(0); PG8_MMA(0, 1, At, B1); PG8_BAR;
            PG8_LDA(At, 0, 1); PG8_STAGE(PG8_SA(0, 0), a2, voffA);
            PG8_BAR; PG8_WAIT_L(0); PG8_MMA(1, 0, At, B0); PG8_BAR; PG8_SCHED;
            PG8_STAGE(PG8_SB(0, 1), b2 + hstep, voffB);
            PG8_WAIT_V(6); PG8_BAR; PG8_MMA(1, 1, At, B1); PG8_BAR;
            PG8_LDB(B0, 1, 0); PG8_SCHED; PG8_LDA(At, 1, 0); PG8_STAGE(PG8_SA(0, 1), a2 + hstep, voffA);
            PG8_WAIT_L(8); PG8_BAR; PG8_WAIT_L(0); PG8_MMA(0, 0, At, B0); PG8_BAR; PG8_SCHED;
            PG8_LDB(B1, 1, 1); PG8_STAGE(PG8_SB(1, 0), b3, voffB);
            PG8_BAR; PG8_WAIT_L(0); PG8_MMA(0, 1, At, B1); PG8_BAR;
            PG8_LDA(At, 1, 1); PG8_STAGE(PG8_SA(1, 0), a3, voffA);
            PG8_BAR; PG8_WAIT_L(0); PG8_MMA(1, 0, At, B0); PG8_BAR; PG8_SCHED;
            PG8_STAGE(PG8_SB(1, 1), b3 + hstep, voffB);
            PG8_WAIT_V(6); PG8_BAR; PG8_MMA(1, 1, At, B1); PG8_BAR;
            }
        }
        }
        if constexpr (ALIGN_EPI) { if (wr == 0) PG8_BAR; }
        if constexpr (!Epi::AFTER_DRAIN) { E(acc, cur, wr, wc, fr, fq); S.done(cur); }
        if (!has_next) break;
#pragma unroll
        for (int a = 0; a < 2; ++a)
#pragma unroll
            for (int b = 0; b < 2; ++b)
#pragma unroll
                for (int m = 0; m < 4; ++m)
#pragma unroll
                    for (int n = 0; n < 2; ++n) acc[a][b][m][n] = (f32x4){0.f, 0.f, 0.f, 0.f};
        cur = nxt; cA = nA; cB = nB; ++ui;
        if constexpr (ALIGN_EPI) { if (wr == 1) PG8_BAR; }
    }
    PG8_WAIT_V(0);
    if constexpr (!ALIGN_EPI) { if (wr == 0) PG8_BAR; }
    PG8_BAR;
    if constexpr (Epi::AFTER_DRAIN) { E.fused(acc, cur, wr, wc, fr, fq, lds, wid, lane); S.done(cur); }
#undef PG8_SA
#undef PG8_SB
#undef PG8_STAGE
#undef PG8_LDA
#undef PG8_LDB
#undef PG8_MMA
#undef PG8_WAIT_V
#undef PG8_WAIT_L
#undef PG8_BAR
#undef PG8_SCHED
}
}
constexpr int NWAVES = 8;
constexpr int M = 16384, D = 2048, FF = 5632, SEQ = 2048, NB = 8, LW = 1024;
constexpr int N_PHASES = 11;
#ifndef MK_COOP
#define MK_COOP 1
#endif
constexpr size_t MiB = 1u << 20;
constexpr size_t WS_SS = 0;
constexpr size_t WS_SP8 = 6 * 65536;
constexpr size_t WS_BAR = 768 * 1024;
constexpr size_t WS_GWP = 1 * MiB;
constexpr size_t WS_AGG = 2 * MiB;
constexpr size_t WS_W1I = 8 * MiB, WS_W1O = 52 * MiB, WS_WMI = 74 * MiB, WS_WMO = 94 * MiB, WS_W2I = 102 * MiB, WS_W2O = 146 * MiB;
constexpr size_t WS_HB = 168 * MiB;
constexpr size_t WS_Y = 232 * MiB;
constexpr size_t WS_ACT = 296 * MiB;
constexpr size_t WS_END = 472 * MiB;

#define LAS __attribute__((address_space(3)))
using pg8::gld; using pg8::gld_nt; using pg8::gst; using pg8::gst_nt; using pg8::gatomic_add;
typedef unsigned short bf16_t;
typedef short bf16x8 __attribute__((ext_vector_type(8)));
typedef float f32x4 __attribute__((ext_vector_type(4)));
typedef unsigned u32x4 __attribute__((ext_vector_type(4)));
typedef unsigned u32x2 __attribute__((ext_vector_type(2)));
constexpr int RING_BYTES = 131072;
constexpr int LDS_BYTES = 163840;
constexpr int L_BARST = LDS_BYTES - 64;

#define LDS_WAIT() asm volatile("s_waitcnt lgkmcnt(0)" ::: "memory")
#define SCHED_FENCE() __builtin_amdgcn_sched_barrier(0)
__device__ __forceinline__ unsigned pk2(float lo, float hi) { return pg8::cvt_pk_bf16(lo, hi); }
__device__ __forceinline__ float bf_lo(unsigned w) { return __uint_as_float(w << 16); }
__device__ __forceinline__ float bf_hi(unsigned w) { return __uint_as_float(w & 0xffff0000u); }
__device__ __forceinline__ float wave_sum(float v) {
#pragma unroll
    for (int o = 1; o < 64; o <<= 1) v += __shfl_xor(v, o);
    return v;
}
__device__ __forceinline__ bf16x8 mk8(float a0, float a1, float a2, float a3, float a4, float a5, float a6, float a7) {
    u32x4 w; w.x = pk2(a0, a1); w.y = pk2(a2, a3); w.z = pk2(a4, a5); w.w = pk2(a6, a7);
    return __builtin_bit_cast(bf16x8, w);
}
#define MFMA16(x, y, c) __builtin_amdgcn_mfma_f32_16x16x32_bf16((x), (y), (c), 0, 0, 0)

#define XB_TMO      128
#define XB_XCNT(j)  (256  + 64 * (j))
#define XB_XSUB(j)  (1280 + 64 * (j))
#define XB_XGEN(j)  (2304 + 64 * (j))
#define XB_TOP      3328
#define XB_TOPGEN   3392
#define XCD_BAR_WORDS 3456
#define XB_SPIN_CAP (1u << 18)

__device__ __forceinline__ unsigned xb_ld(unsigned* p)              { return __hip_atomic_load(p, __ATOMIC_RELAXED, __HIP_MEMORY_SCOPE_AGENT); }
__device__ __forceinline__ unsigned xb_add(unsigned* p, unsigned v) { return __hip_atomic_fetch_add(p, v, __ATOMIC_RELAXED, __HIP_MEMORY_SCOPE_AGENT); }
__device__ __forceinline__ unsigned xb_xcc_id() { return (unsigned)__builtin_amdgcn_s_getreg((3 << 11) | 20) & 0xFu; }
#define XB_SPIN(cond, bar) do { unsigned _sp = 0; while (cond) { __builtin_amdgcn_s_sleep(1); \
    if ((++_sp & 255u) == 0u) { if (xb_ld(&(bar)[XB_TMO])) break; if (_sp > XB_SPIN_CAP) { atomicAdd(&(bar)[XB_TMO], 1u); break; } } } } while (0)

struct XcdBarrier {
    unsigned* bar; unsigned x;
    volatile LAS unsigned* st;
};

__device__ __forceinline__ XcdBarrier xcd_barrier_post(unsigned* bar, volatile LAS unsigned* st, int tid) {
    XcdBarrier b; b.bar = bar; b.x = xb_xcc_id(); b.st = st;
    if (tid == 0) (void)xb_add(&bar[XB_XCNT(b.x)], 1u);
    return b;
}
__device__ __forceinline__ void xcd_barrier_complete(unsigned* bar, unsigned x, unsigned& nloc, unsigned& nx) {
    const unsigned G = gridDim.x * gridDim.y * gridDim.z;
    unsigned sum, cnt, mine, sp = 0u;
    for (;;) {
        sum = 0u; cnt = 0u; mine = 0u;
#pragma unroll
        for (unsigned j = 0; j < 16; ++j) { const unsigned c = xb_ld(&bar[XB_XCNT(j)]); sum += c; cnt += (c > 0u) ? 1u : 0u; mine = (j == x) ? c : mine; }
        if (sum == G) break;
        __builtin_amdgcn_s_sleep(1);
        if ((++sp & 255u) == 0u) { if (xb_ld(&bar[XB_TMO])) break; if (sp > XB_SPIN_CAP) { atomicAdd(&bar[XB_TMO], 1u); break; } }
    }
    nloc = mine > 0u ? mine : 1u; nx = cnt > 0u ? cnt : 1u;
}

__device__ __forceinline__ void xcd_barrier(const XcdBarrier& b, int tid) {
    asm volatile("s_waitcnt vmcnt(0)" ::: "memory");
    __syncthreads();
    if (tid == 0) {
        unsigned* bar = b.bar;
        __builtin_amdgcn_s_waitcnt(0);
        unsigned nloc = b.st[0], nx = b.st[1];
        if (nloc == 0u) { xcd_barrier_complete(bar, b.x, nloc, nx); b.st[0] = nloc; b.st[1] = nx; }
        const unsigned old = xb_add(&bar[XB_XSUB(b.x)], 1u);
        const unsigned gen = old / nloc;
        if (old + 1u == (gen + 1u) * nloc) {
            __builtin_amdgcn_fence(__ATOMIC_RELEASE, "agent");
            asm volatile("s_waitcnt vmcnt(0)" ::: "memory");
            const unsigned og = xb_add(&bar[XB_TOP], 1u);
            const unsigned tg = og / nx;
            if (og + 1u == (tg + 1u) * nx) xb_add(&bar[XB_TOPGEN], 1u);
            else XB_SPIN(xb_ld(&bar[XB_TOPGEN]) == tg, bar);
            __builtin_amdgcn_fence(__ATOMIC_ACQUIRE, "agent");
            xb_add(&bar[XB_XGEN(b.x)], 1u);
            asm volatile("s_waitcnt vmcnt(0)" ::: "memory");
        } else {
            XB_SPIN(xb_ld(&bar[XB_XGEN(b.x)]) == gen, bar);
            __builtin_amdgcn_fence(__ATOMIC_ACQUIRE, "agent");
            asm volatile("s_waitcnt vmcnt(0)" ::: "memory");
        }
    }
    __syncthreads();
}

struct Args { const float* in[19]; float* out; unsigned char* ws; int ph_lo, ph_hi, coop, pad; };
typedef const __attribute__((address_space(4))) Args* KArgs;

struct P0Item { const float* W; const float* gk; bf16_t* WT; int K, N, dest_row0, k0, n0; };
__device__ __forceinline__ int swiglu_dest(int n0) { return n0 < FF ? (n0 >> 7) * 256 + (n0 & 127) : ((n0 - FF) >> 7) * 256 + 128 + ((n0 - FF) & 127); }
__device__ __forceinline__ P0Item p0_decode(KArgs a, unsigned char* ws, int it) {
    constexpr int I_FI = (D / 64) * (2 * FF / 64), I_FO = (FF / 64) * (D / 64), I_MI = (D / 64) * (5120 / 64);
    int r = it; P0Item I;
    if (r < 2 * I_FI) { const bool f1 = r < I_FI; if (!f1) r -= I_FI; const int nblk = 2 * FF / 64, kb = r / nblk, nb = r % nblk;
        I.W = a->in[f1 ? 2 : 16]; I.gk = a->in[f1 ? 1 : 15] + 64 * kb; I.WT = (bf16_t*)(ws + (f1 ? WS_W1I : WS_W2I)); I.K = D; I.N = 2 * FF; I.dest_row0 = swiglu_dest(64 * nb); I.k0 = 64 * kb; I.n0 = 64 * nb; return I; }
    r -= 2 * I_FI;
    if (r < 2 * I_FO) { const bool f1 = r < I_FO; if (!f1) r -= I_FO; const int nblk = D / 64, kb = r / nblk, nb = r % nblk;
        I.W = a->in[f1 ? 3 : 17]; I.gk = nullptr; I.WT = (bf16_t*)(ws + (f1 ? WS_W1O : WS_W2O)); I.K = FF; I.N = D; I.dest_row0 = 64 * nb; I.k0 = 64 * kb; I.n0 = 64 * nb; return I; }
    r -= 2 * I_FO;
    if (r < I_MI) { const int nblk = 5120 / 64, kb = r / nblk, nb = r % nblk;
        I.W = a->in[5]; I.gk = a->in[4] + 64 * kb; I.WT = (bf16_t*)(ws + WS_WMI); I.K = D; I.N = 5120; I.dest_row0 = 64 * nb; I.k0 = 64 * kb; I.n0 = 64 * nb; return I; }
    r -= I_MI;
    { const int nblk = D / 64, kb = r / nblk, nb = r % nblk;
      I.W = a->in[14]; I.gk = (kb < 16) ? a->in[12] + 64 * kb : a->in[13] + 64 * (kb - 16); I.WT = (bf16_t*)(ws + WS_WMO); I.K = D; I.N = D; I.dest_row0 = 64 * nb; I.k0 = 64 * kb; I.n0 = 64 * nb; return I; }
}
__device__ __forceinline__ void p0_load(const P0Item& I, int lane, f32x4 (&v)[16], float (&g)[16]) {
    const int lr = lane >> 4, lc = (lane & 15) * 4;
#pragma unroll
    for (int i = 0; i < 16; ++i) { v[i] = gld_nt<f32x4>(I.W + (size_t)(I.k0 + 4 * i + lr) * I.N + I.n0 + lc); g[i] = I.gk ? gld<float>(I.gk + 4 * i + lr) : 1.0f; }
}
__device__ __forceinline__ void p0_finish(const P0Item& I, LAS float* scr, int lane, const f32x4 (&v)[16], const float (&g)[16]) {
    const int lr = lane >> 4, lc = (lane & 15) * 4;
#pragma unroll
    for (int i = 0; i < 16; ++i) { LAS float* d = scr + (4 * i + lr) * 65 + lc; d[0] = v[i][0] * g[i]; d[1] = v[i][1] * g[i]; d[2] = v[i][2] * g[i]; d[3] = v[i][3] * g[i]; }
    LDS_WAIT(); asm volatile("" ::: "memory");
    const int c = lane & 7;
#pragma unroll
    for (int j = 0; j < 8; ++j) { const int n = (lane >> 3) + 8 * j; const LAS float* s = scr + (8 * c) * 65 + n;
        u32x4 o; o.x = pk2(s[0 * 65], s[1 * 65]); o.y = pk2(s[2 * 65], s[3 * 65]); o.z = pk2(s[4 * 65], s[5 * 65]); o.w = pk2(s[6 * 65], s[7 * 65]);
        gst<u32x4>(I.WT + (size_t)(I.dest_row0 + n) * I.K + I.k0 + 8 * c, o); }
    LDS_WAIT(); asm volatile("" ::: "memory");
}

__device__ __forceinline__ void p0_prologue(KArgs a, unsigned char* ws, LAS unsigned char* lds, int wave, int lane, int bx) {
    LAS float* scr = (LAS float*)(lds + wave * 16640);
    const int gw = bx * NWAVES + wave, NGW = gridDim.x * NWAVES;
    constexpr int I_FI = (D / 64) * (2 * FF / 64), I_FO = (FF / 64) * (D / 64), I_MI = (D / 64) * (5120 / 64), I_MO = (D / 64) * (D / 64);
    constexpr int NITEMS = 2 * (I_FI + I_FO) + I_MI + I_MO;
    {
        int it = gw;
        if (it < NITEMS) {
            P0Item cur = p0_decode(a, ws, it); f32x4 va[16]; float ga[16];
            p0_load(cur, lane, va, ga);
            for (;;) {
                const int nit = it + NGW; const bool has = nit < NITEMS;
                P0Item nxt = cur; f32x4 vb[16]; float gb[16];
                if (has) { nxt = p0_decode(a, ws, nit); p0_load(nxt, lane, vb, gb); }
                p0_finish(cur, scr, lane, va, ga);
                if (!has) break;
                cur = nxt; it = nit;
#pragma unroll
                for (int i = 0; i < 16; ++i) { va[i] = vb[i]; ga[i] = gb[i]; }
            }
        }
    }
    float* ssx = (float*)(ws + WS_SS);
    for (int m0 = gw; m0 < M; m0 += 4 * NGW) {
        int mr[4]; f32x4 v[4][8];
#pragma unroll
        for (int q = 0; q < 4; ++q) { mr[q] = (m0 + q * NGW < M) ? m0 + q * NGW : m0;
#pragma unroll
            for (int j = 0; j < 8; ++j) v[q][j] = gld_nt<f32x4>((const f32x4*)(a->in[0] + (size_t)mr[q] * D) + lane + 64 * j); }
#pragma unroll
        for (int q = 0; q < 4; ++q) {
            float s = 0.f;
#pragma unroll
            for (int j = 0; j < 8; ++j) s += (v[q][j][0] * v[q][j][0] + v[q][j][1] * v[q][j][1]) + (v[q][j][2] * v[q][j][2] + v[q][j][3] * v[q][j][3]);
            s = wave_sum(s);
            if (q == 0 || mr[q] != m0) {
                if (lane == 0) gst<float>(ssx + mr[q], s);
                u32x2* o8 = (u32x2*)((bf16_t*)(ws + WS_HB) + (size_t)mr[q] * D) + lane;
#pragma unroll
                for (int j = 0; j < 8; ++j) { u32x2 p; p.x = pk2(v[q][j][0], v[q][j][1]); p.y = pk2(v[q][j][2], v[q][j][3]); gst<u32x2>(o8 + 64 * j, p); }
            }
        }
    }
    const int gt = bx * (NWAVES * 64) + wave * 64 + lane, NGT = gridDim.x * NWAVES * 64;
    { float* z = (float*)(ws + WS_SS) + 16384; for (int i = gt; i < 5 * 16384; i += NGT) gst<float>(z + i, 0.f); }
    { float* sp8 = (float*)(ws + WS_SP8); for (int i = gt; i < 2048; i += NGT) gst<float>(sp8 + i, 8.0f * 1.44269504089f * log1pf(expf(-gld<float>(a->in[10] + i)))); }
    {
        const float* gw_ = a->in[8]; u32x4* gwp = (u32x4*)(ws + WS_GWP);
        for (int idx = gt; idx < 32768; idx += NGT) {
            const int ln = idx & 63, ks = (idx >> 6) & 1, jb = (idx >> 7) & 3, g = (idx >> 9) & 1, z = (idx >> 10) & 1, h = idx >> 11;
            const int fr = ln & 15, fq = ln >> 4; float v[8];
#pragma unroll
            for (int s = 0; s < 8; ++s) { const int i = 16 * (2 * ks + (s >> 2)) + 4 * fq + (s & 3), j = 16 * jb + fr; v[s] = -1.44269504089f * gld<float>(gw_ + ((size_t)(((z * 2 + g) * 16 + h) * 64 + i)) * 64 + j); }
            u32x4 w; w.x = pk2(v[0], v[1]); w.y = pk2(v[2], v[3]); w.z = pk2(v[4], v[5]); w.w = pk2(v[6], v[7]); gst<u32x4>(gwp + idx, w);
        }
    }
}

__device__ __forceinline__ float sigm(float x) { return __builtin_amdgcn_rcpf(1.0f + __builtin_amdgcn_exp2f(x * -1.44269504089f)); }
template <int CTRL> __device__ __forceinline__ float dpp_f(float old, float src) {
    return __builtin_bit_cast(float, __builtin_amdgcn_update_dpp(__builtin_bit_cast(int, old), __builtin_bit_cast(int, src), CTRL, 0xF, 0xF, false));
}
template <int DIR, int DD> __device__ __forceinline__ void scan_step(float& av, float& bv) {
    constexpr int CTRL = (DIR == 0 ? 0x110 : 0x100) + DD;
    const float bp = dpp_f<CTRL>(0.0f, bv), ap = dpp_f<CTRL>(1.0f, av);
    bv = av * bp + bv; av = av * ap;
}
__device__ __forceinline__ float neg_expm1(float x) {
    const float p = -x * (1.0f + x * 0.5f * (1.0f + x * (1.0f / 3.0f) * (1.0f + x * 0.25f * (1.0f + x * 0.2f * (1.0f + x * (1.0f / 6.0f))))));
    return x > -0.3f ? p : 1.0f - __expf(x);
}
struct LruCtx { const bf16_t* xl; const bf16_t* gl; const float* convw; const float* convb; const u32x4* gwp; const float* gateb; const float* sp8; float* aggA; float* aggB; bf16_t* y; float* ssA; };

constexpr int L_GWP = 0, L_CW = 32768, L_CB = 33792, L_GB = 34048, L_SP = 35072, L_HF = 36864, L_HF_WAVE = 8192, L_RPB = 102400;
constexpr int XT_ROWB = 144, XT_TILE = 3584, L_XT2 = 102400, L_XT2_WAVE = 7168;
static_assert(L_XT2 + NWAVES * L_XT2_WAVE <= L_BARST && 2 * XT_TILE <= L_XT2_WAVE && 2 * XT_TILE <= L_HF_WAVE, "LDS map (x tiles)");
static_assert(L_HF + NWAVES * L_HF_WAVE == L_RPB && L_RPB + 16 * 15 * 32 * 4 <= LDS_BYTES, "LDS map");
__device__ __forceinline__ void lru_stage_consts(const LruCtx& C, LAS unsigned char* lds, int h, int tid) {
    LAS u32x4* g = (LAS u32x4*)(lds + L_GWP);
    for (int i = tid; i < 2048; i += NWAVES * 64) g[i] = gld<u32x4>(C.gwp + (size_t)h * 2048 + i);
    LAS float* cw = (LAS float*)(lds + L_CW); LAS float* cb = (LAS float*)(lds + L_CB); LAS float* gb = (LAS float*)(lds + L_GB); LAS float* sp = (LAS float*)(lds + L_SP);
    if (tid < 256) cw[tid] = gld<float>(C.convw + (tid >> 6) * LW + h * 64 + (tid & 63));
    if (tid < 64) cb[tid] = gld<float>(C.convb + h * 64 + tid);
    if (tid < 256) gb[tid] = -1.44269504089f * gld<float>(C.gateb + ((tid >> 6) * 16 + h) * 64 + (tid & 63));
    if (tid < 128) sp[tid] = gld<float>(C.sp8 + (tid >> 6) * LW + h * 64 + (tid & 63));
}
struct XRegs { u32x4 v[3]; };
__device__ __forceinline__ void lru_ldx(XRegs& R, const LruCtx& C, int b, int h, int s0, int lane) {
#pragma unroll
    for (int i = 0; i < 3; ++i) { const int s = s0 - 2 + 8 * i + (lane >> 3); const bool ok = (s >= 0) && (s < SEQ);
        const u32x4 v = gld<u32x4>(C.xl + ((size_t)(b * SEQ + (ok ? s : s0))) * LW + h * 64 + (lane & 7) * 8);
        R.v[i] = ok ? v : (u32x4){0u, 0u, 0u, 0u}; }
}
__device__ __forceinline__ void lru_stx(const XRegs& R, int lane, LAS unsigned char* xt) {
#pragma unroll
    for (int i = 0; i < 3; ++i) *(LAS u32x4*)(xt + (8 * i + (lane >> 3)) * XT_ROWB + (lane & 7) * 16) = R.v[i];
}
struct ConvRegs { f32x4 w[4]; f32x4 b; u32x2 x[4]; };
struct GateRegs { u32x4 g[4]; f32x4 br, bi, sp; u32x2 hf; };
__device__ __forceinline__ void ld_conv(ConvRegs& R, const LAS float* cw, const LAS float* cb, const LAS unsigned char* xrow, int jb) {
    R.b = *(const LAS f32x4*)(cb + 16 * jb);
#pragma unroll
    for (int tap = 0; tap < 4; ++tap) { R.w[tap] = *(const LAS f32x4*)(cw + tap * 64 + 16 * jb); R.x[tap] = *(const LAS u32x2*)(xrow + tap * XT_ROWB + 32 * jb); }
}
template <bool WITH_HF>
__device__ __forceinline__ void ld_gate(GateRegs& R, const LAS u32x4* gw, const LAS float* gb, const LAS float* sp_, const LAS unsigned* hfl, int hidx, int jb) {
    R.g[0] = gw[(0 * 4 + jb) * 2 * 64]; R.g[1] = gw[(0 * 4 + jb) * 2 * 64 + 64]; R.g[2] = gw[(1 * 4 + jb) * 2 * 64]; R.g[3] = gw[(1 * 4 + jb) * 2 * 64 + 64];
    R.br = *(const LAS f32x4*)(gb + 16 * jb); R.bi = *(const LAS f32x4*)(gb + 64 + 16 * jb); R.sp = *(const LAS f32x4*)(sp_ + 16 * jb);
    if (WITH_HF) { R.hf.x = hfl[hidx + (jb * 2 + 0) * 64]; R.hf.y = hfl[hidx + (jb * 2 + 1) * 64]; }
}
template <int PASS, int DIR, int MODE>
__device__ __forceinline__ void lru_step(const LruCtx& C, const LAS unsigned char* cst, const LAS unsigned char* xt, int b, int h, int chunk, int tbi, int lane, float (&carry)[4][4], float (&atot)[4][4], LAS unsigned* hfl) {
    const int fr = lane & 15, fq = lane >> 4;
    const int s_tok = chunk * 64 + tbi * 16 + fr;
    const size_t rowoff = ((size_t)(b * SEQ + s_tok)) * LW + h * 64 + 4 * fq;
    u32x2 gr[4];
    if (PASS == 2 && MODE == 1) {
#pragma unroll
        for (int jb = 0; jb < 4; ++jb) gr[jb] = gld<u32x2>(C.gl + rowoff + 16 * jb);
    }
    const LAS unsigned char* xrow = xt + fr * XT_ROWB + 8 * fq;
    const LAS float* cw = (const LAS float*)(cst + L_CW) + 4 * fq; const LAS float* cb = (const LAS float*)(cst + L_CB) + 4 * fq;
    const LAS float* gb = (const LAS float*)(cst + L_GB) + (DIR * 2) * 64 + 4 * fq; const LAS float* sp_ = (const LAS float*)(cst + L_SP) + DIR * 64 + 4 * fq;
    const LAS u32x4* gw = (const LAS u32x4*)(cst + L_GWP) + (size_t)(DIR * 2) * 8 * 64 + lane;
    float xc[4][4];
    {
        ConvRegs ca; ld_conv(ca, cw, cb, xrow, 0);
#pragma unroll
        for (int jb = 0; jb < 4; ++jb) {
            ConvRegs cn; if (jb < 3) ld_conv(cn, cw, cb, xrow, jb + 1);
            SCHED_FENCE();
            f32x4 av = ca.b;
#pragma unroll
            for (int tap = 0; tap < 4; ++tap) { const u32x2 raw = ca.x[tap]; av = av + ca.w[tap] * (f32x4){bf_lo(raw.x), bf_hi(raw.x), bf_lo(raw.y), bf_hi(raw.y)}; }
#pragma unroll
            for (int e = 0; e < 4; ++e) xc[jb][e] = av[e];
            SCHED_FENCE();
            if (jb < 3) ca = cn;
        }
    }
    const bf16x8 xb0 = mk8(xc[0][0], xc[0][1], xc[0][2], xc[0][3], xc[1][0], xc[1][1], xc[1][2], xc[1][3]);
    const bf16x8 xb1 = mk8(xc[2][0], xc[2][1], xc[2][2], xc[2][3], xc[3][0], xc[3][1], xc[3][2], xc[3][3]);
    float ssq = 0.f;
    constexpr bool WHF = (PASS == 2 && MODE == 1);
    const int hidx = tbi * 8 * 64 + lane;
    GateRegs ga; ld_gate<WHF>(ga, gw, gb, sp_, hfl, hidx, 0);
#pragma unroll
    for (int jb = 0; jb < 4; ++jb) {
        GateRegs gn; if (jb < 3) ld_gate<WHF>(gn, gw, gb, sp_, hfl, hidx, jb + 1);
        SCHED_FENCE();
        const f32x4 sp = ga.sp;
        f32x4 ar = ga.br, ai = ga.bi;
        ar = MFMA16(__builtin_bit_cast(bf16x8, ga.g[0]), xb0, ar); ar = MFMA16(__builtin_bit_cast(bf16x8, ga.g[1]), xb1, ar);
        ai = MFMA16(__builtin_bit_cast(bf16x8, ga.g[2]), xb0, ai); ai = MFMA16(__builtin_bit_cast(bf16x8, ga.g[3]), xb1, ai);
        float hv[4];
#pragma unroll
        for (int e = 0; e < 4; ++e) {
            const float rg = __builtin_amdgcn_rcpf(1.0f + __builtin_amdgcn_exp2f(ar[e])), ig = __builtin_amdgcn_rcpf(1.0f + __builtin_amdgcn_exp2f(ai[e]));
            float av = __builtin_amdgcn_exp2f(-rg * sp[e]);
            float bv = __builtin_amdgcn_sqrtf(fmaxf(1.0f - av * av, 0.0f)) * (ig * xc[jb][e]);
            scan_step<DIR, 1>(av, bv); scan_step<DIR, 2>(av, bv); scan_step<DIR, 4>(av, bv); scan_step<DIR, 8>(av, bv);
            hv[e] = bv + av * carry[jb][e];
            carry[jb][e] = dpp_f<(DIR == 0 ? 0x15F : 0x150)>(0.0f, hv[e]);
            if (PASS == 1) atot[jb][e] = atot[jb][e] * dpp_f<(DIR == 0 ? 0x15F : 0x150)>(1.0f, av);
        }
        if (PASS == 2 && MODE == 0) { hfl[(tbi * 8 + jb * 2 + 0) * 64 + lane] = pk2(hv[0], hv[1]); hfl[(tbi * 8 + jb * 2 + 1) * 64 + lane] = pk2(hv[2], hv[3]); }
        if (PASS == 2 && MODE == 1) {
            const unsigned h01 = ga.hf.x, h23 = ga.hf.y;
            const float ho[4] = {bf_lo(h01), bf_hi(h01), bf_lo(h23), bf_hi(h23)};
            const float gvv[4] = {bf_lo(gr[jb].x), bf_hi(gr[jb].x), bf_lo(gr[jb].y), bf_hi(gr[jb].y)};
            float yo[4];
#pragma unroll
            for (int e = 0; e < 4; ++e) { const float g = gvv[e]; const float ge = g * sigm(1.5957691216f * (g + 0.044715f * g * g * g)); yo[e] = ge * (ho[e] + hv[e]); ssq += yo[e] * yo[e]; }
            u32x2 w; w.x = pk2(yo[0], yo[1]); w.y = pk2(yo[2], yo[3]);
            gst<u32x2>(C.y + ((size_t)(b * SEQ + s_tok)) * D + h * 64 + 16 * jb + 4 * fq, w);
        }
        SCHED_FENCE();
        if (jb < 3) ga = gn;
    }
    if (PASS == 2 && MODE == 1) { ssq += __shfl_xor(ssq, 16); ssq += __shfl_xor(ssq, 32); if (fq == 0) gatomic_add(C.ssA + b * SEQ + s_tok, ssq); }
}

template <int DIR>
__device__ __forceinline__ void lru_carry_in(const LruCtx& C, int b, int h, int chunk, int lane, float (&carry)[4][4]) {
    const int fr = lane & 15, fq = lane >> 4;
    const int n = DIR == 0 ? chunk : 31 - chunk;
    const int k0 = 2 * fr, k1 = 2 * fr + 1;
    const int c0 = DIR == 0 ? k0 : 31 - k0, c1 = DIR == 0 ? k1 : 31 - k1;
    const bool ok0 = k0 < n, ok1 = k1 < n;
    const size_t o0 = ((size_t)((DIR * NB + b) * 32 + (ok0 ? c0 : chunk))) * LW + h * 64 + 4 * fq, o1 = ((size_t)((DIR * NB + b) * 32 + (ok1 ? c1 : chunk))) * LW + h * 64 + 4 * fq;
#pragma unroll
    for (int jh = 0; jh < 2; ++jh) {
        f32x4 A0[2], B0[2], A1[2], B1[2];
#pragma unroll
        for (int j2 = 0; j2 < 2; ++j2) { const int jb = 2 * jh + j2; A0[j2] = gld<f32x4>(C.aggA + o0 + 16 * jb); B0[j2] = gld<f32x4>(C.aggB + o0 + 16 * jb); A1[j2] = gld<f32x4>(C.aggA + o1 + 16 * jb); B1[j2] = gld<f32x4>(C.aggB + o1 + 16 * jb); }
        SCHED_FENCE();
#pragma unroll
        for (int j2 = 0; j2 < 2; ++j2)
#pragma unroll
            for (int e = 0; e < 4; ++e) {
                const int jb = 2 * jh + j2;
                const float a0 = ok0 ? A0[j2][e] : 1.0f, b0 = ok0 ? B0[j2][e] : 0.0f, a1 = ok1 ? A1[j2][e] : 1.0f, b1 = ok1 ? B1[j2][e] : 0.0f;
                float av = a0 * a1, bv = a1 * b0 + b1;
                scan_step<0, 1>(av, bv); scan_step<0, 2>(av, bv); scan_step<0, 4>(av, bv); scan_step<0, 8>(av, bv);
                carry[jb][e] = dpp_f<0x15F>(0.0f, bv);
            }
        SCHED_FENCE();
    }
}
template <int PASS>
__device__ __forceinline__ void lru_unit(const LruCtx& C, int b, int h, int chunk, int lane, const LAS unsigned char* cst_, LAS unsigned char* wl, LAS unsigned char* xt) {
    const int fr = lane & 15, fq = lane >> 4;
    LAS unsigned* hfl = (LAS unsigned*)wl;
    float cf[4][4], cb[4][4], af[4][4], ab[4][4];
#pragma unroll
    for (int jb = 0; jb < 4; ++jb)
#pragma unroll
        for (int e = 0; e < 4; ++e) { cf[jb][e] = 0.f; cb[jb][e] = 0.f; af[jb][e] = 1.f; ab[jb][e] = 1.f; }
    if (PASS == 2) { lru_carry_in<0>(C, b, h, chunk, lane, cf); lru_carry_in<1>(C, b, h, chunk, lane, cb); }
    unsigned co = 0;
    if (PASS == 1) {
        XRegs x0, x1; lru_ldx(x0, C, b, h, chunk * 64, lane); lru_ldx(x1, C, b, h, chunk * 64 + 48, lane);
#pragma unroll 1
        for (int t = 0; t < 4; ++t) {
            asm volatile("" : "+s"(co));
            const LAS unsigned char* cst = cst_ + co;
            lru_stx(x0, lane, xt); lru_stx(x1, lane, xt + XT_TILE);
            { const int tn = t < 3 ? t + 1 : 3; lru_ldx(x0, C, b, h, chunk * 64 + tn * 16, lane); lru_ldx(x1, C, b, h, chunk * 64 + (3 - tn) * 16, lane); }
            SCHED_FENCE();
            lru_step<1, 0, 0>(C, cst, xt, b, h, chunk, t, lane, cf, af, hfl);
            lru_step<1, 1, 0>(C, cst, xt + XT_TILE, b, h, chunk, 3 - t, lane, cb, ab, hfl);
        }
        if (fr == 0) {
            const size_t o0 = ((size_t)((0 * NB + b) * 32 + chunk)) * LW + h * 64 + 4 * fq, o1 = ((size_t)((1 * NB + b) * 32 + chunk)) * LW + h * 64 + 4 * fq;
#pragma unroll
            for (int jb = 0; jb < 4; ++jb) {
                gst<f32x4>(C.aggA + o0 + 16 * jb, (f32x4){af[jb][0], af[jb][1], af[jb][2], af[jb][3]}); gst<f32x4>(C.aggB + o0 + 16 * jb, (f32x4){cf[jb][0], cf[jb][1], cf[jb][2], cf[jb][3]});
                gst<f32x4>(C.aggA + o1 + 16 * jb, (f32x4){ab[jb][0], ab[jb][1], ab[jb][2], ab[jb][3]}); gst<f32x4>(C.aggB + o1 + 16 * jb, (f32x4){cb[jb][0], cb[jb][1], cb[jb][2], cb[jb][3]});
            }
        }
    } else {
        XRegs x0, x1; lru_ldx(x0, C, b, h, chunk * 64, lane); lru_ldx(x1, C, b, h, chunk * 64 + 48, lane);
#pragma unroll 1
        for (int t = 0; t < 2; ++t) {
            asm volatile("" : "+s"(co));
            const LAS unsigned char* cst = cst_ + co;
            lru_stx(x0, lane, xt); lru_stx(x1, lane, xt + XT_TILE);
            lru_ldx(x0, C, b, h, chunk * 64 + (t + 1) * 16, lane); lru_ldx(x1, C, b, h, chunk * 64 + (2 - t) * 16, lane);
            SCHED_FENCE();
            lru_step<2, 0, 0>(C, cst, xt, b, h, chunk, t, lane, cf, af, hfl);
            SCHED_FENCE();
            lru_step<2, 1, 0>(C, cst, xt + XT_TILE, b, h, chunk, 3 - t, lane, cb, ab, hfl);
        }
#pragma unroll 1
        for (int t = 2; t < 4; ++t) {
            asm volatile("" : "+s"(co));
            const LAS unsigned char* cst = cst_ + co;
            lru_stx(x0, lane, xt); lru_stx(x1, lane, xt + XT_TILE);
            lru_ldx(x0, C, b, h, chunk * 64 + 48, lane); lru_ldx(x1, C, b, h, chunk * 64, lane);
            SCHED_FENCE();
            lru_step<2, 0, 1>(C, cst, xt, b, h, chunk, t, lane, cf, af, hfl);
            SCHED_FENCE();
            lru_step<2, 1, 1>(C, cst, xt + XT_TILE, b, h, chunk, 3 - t, lane, cb, ab, hfl);
        }
    }
}
template <int PASS>
__device__ __forceinline__ void lru_phase(const LruCtx& C, LAS unsigned char* lds, int wave, int lane, int G, int bx) {
    const int h = bx & 15, jblk = bx >> 4, nblk = G >> 4;
    for (int combo = jblk * NWAVES + wave; combo < 256; combo += nblk * NWAVES) lru_unit<PASS>(C, combo >> 5, h, combo & 31, lane, lds, lds + L_HF + wave * L_HF_WAVE, PASS == 1 ? lds + L_HF + wave * L_HF_WAVE : lds + L_XT2 + wave * L_XT2_WAVE);
}

struct AttnCtx { const bf16_t* q; const bf16_t* k; const bf16_t* vT; const LAS float* rpb; bf16_t* y; float* ssB; };
__device__ __forceinline__ void attn_unit(const AttnCtx& C, int unit, int lane) {
    const int j = unit & 3, h = (unit >> 2) & 15, r = (unit >> 6) & 31, b = unit >> 11;
    const int fr = lane & 15, fq = lane >> 4;
    const int rs = min(max(r - 4, 0), 24), kc0 = min(max(16 * j - 8, 0), 32);
    const int qcol = 16 * j + fr, cs = min(max(qcol - 8, 0), 48);
    const size_t tq = (size_t)b * SEQ + r * 64 + qcol;
    const bf16x8 q0 = gld<bf16x8>(C.q + tq * LW + h * 64 + 8 * fq), q1 = gld<bf16x8>(C.q + tq * LW + h * 64 + 32 + 8 * fq);
    const bf16_t* kbase = C.k + (((size_t)(b * 16 + h) * 2) * SEQ + rs * 64 + kc0 + 8 * (fr >> 2) + (fr & 3)) * 32 + 8 * fq;
    const LAS float* bias_base = C.rpb + (h * 15 + (rs - r + 7)) * 32;
    float sv[8][8];
    float mx = -INFINITY;
    f32x4 o[4];
    {
        bf16x8 kf[8][2][2];
#pragma unroll
        for (int rr = 0; rr < 8; ++rr)
#pragma unroll
            for (int p = 0; p < 2; ++p) { const bf16_t* kp = kbase + (size_t)(rr * 64 + 4 * p) * 32; kf[rr][p][0] = gld<bf16x8>(kp); kf[rr][p][1] = gld<bf16x8>(kp + (size_t)SEQ * 32); }
        SCHED_FENCE();
#pragma unroll
        for (int rr = 0; rr < 8; ++rr) {
#pragma unroll
            for (int p = 0; p < 2; ++p) {
                f32x4 acc = (f32x4){0.f, 0.f, 0.f, 0.f};
                acc = MFMA16(kf[rr][p][0], q0, acc); acc = MFMA16(kf[rr][p][1], q1, acc);
#pragma unroll
                for (int e = 0; e < 4; ++e) {
                    const int kcol = kc0 + 8 * fq + 4 * p + e;
                    const bool valid = (kcol >= cs) && (kcol < cs + 16);
                    const int bi = min(max(kcol - qcol + 15, 0), 30);
                    const float bz = bias_base[rr * 32 + bi];
                    const float v = (acc[e] + bz) + (valid ? 0.0f : -INFINITY);
                    sv[rr][4 * p + e] = v; mx = fmaxf(mx, v);
                }
            }
        }
        SCHED_FENCE();
    }
    {
        bf16x8 vf[8][4];
        const bf16_t* vbase = C.vT + ((((size_t)((b * 16 + h) * 32 + rs)) * 8 + (kc0 >> 3) + fq) * 64 + fr) * 8;
#pragma unroll
        for (int rr = 0; rr < 8; ++rr)
#pragma unroll
            for (int d = 0; d < 4; ++d) vf[rr][d] = gld<bf16x8>(vbase + (size_t)rr * (8 * 64 * 8) + d * (16 * 8));
        SCHED_FENCE();
        mx = fmaxf(mx, __shfl_xor(mx, 16)); mx = fmaxf(mx, __shfl_xor(mx, 32));
        float sum_ = 0.f;
#pragma unroll
        for (int rr = 0; rr < 8; ++rr)
#pragma unroll
            for (int i = 0; i < 8; ++i) { const float p = __builtin_amdgcn_exp2f(sv[rr][i] - mx); sv[rr][i] = p; sum_ += p; }
        sum_ += __shfl_xor(sum_, 16); sum_ += __shfl_xor(sum_, 32);
        sv[0][0] = sv[0][0];
        SCHED_FENCE();
#pragma unroll
        for (int d = 0; d < 4; ++d) o[d] = (f32x4){0.f, 0.f, 0.f, 0.f};
#pragma unroll
        for (int rr = 0; rr < 8; ++rr) {
            const bf16x8 pf = mk8(sv[rr][0], sv[rr][1], sv[rr][2], sv[rr][3], sv[rr][4], sv[rr][5], sv[rr][6], sv[rr][7]);
#pragma unroll
            for (int d = 0; d < 4; ++d) o[d] = MFMA16(vf[rr][d], pf, o[d]);
        }
        mx = sum_;
    }
    const float sum = mx;
    const float inv = __builtin_amdgcn_rcpf(sum); float ssq = 0.f;
#pragma unroll
    for (int d = 0; d < 4; ++d) {
        const f32x4 ov = o[d] * inv; ssq += (ov[0] * ov[0] + ov[1] * ov[1]) + (ov[2] * ov[2] + ov[3] * ov[3]);
        u32x2 w; w.x = pk2(ov[0], ov[1]); w.y = pk2(ov[2], ov[3]);
        gst<u32x2>(C.y + tq * D + LW + h * 64 + 16 * d + 4 * fq, w);
    }
    ssq += __shfl_xor(ssq, 16); ssq += __shfl_xor(ssq, 32);
    if (fq == 0) gatomic_add(C.ssB + tq, ssq);
}

__global__ void __launch_bounds__(NWAVES * 64, 2) mk_fwd(Args args) {
    extern __shared__ __attribute__((aligned(16))) unsigned char lds_raw[];
    LAS unsigned char* lds = (LAS unsigned char*)lds_raw;
    KArgs ka0 = (KArgs)__builtin_amdgcn_kernarg_segment_ptr();
    const int ph_lo = ka0->ph_lo, ph_hi = ka0->ph_hi, coop = ka0->coop;
    const int wave0 = __builtin_amdgcn_readfirstlane((int)(threadIdx.x >> 6));
    if (threadIdx.x < 2) ((volatile LAS unsigned*)(lds + L_BARST))[threadIdx.x] = 0u;
    __syncthreads();
    XcdBarrier bar; bar.bar = (unsigned*)(ka0->ws + WS_BAR); bar.x = 0; bar.st = (volatile LAS unsigned*)(lds + L_BARST);
    if (coop == 1) bar = xcd_barrier_post((unsigned*)(ka0->ws + WS_BAR), (volatile LAS unsigned*)(lds + L_BARST), (int)threadIdx.x);
    for (int ph = ph_lo; ph < ph_hi; ++ph) {
        KArgs ka = ka0; asm volatile("" : "+s"(ka));
        int lane_ = (int)__builtin_amdgcn_mbcnt_hi(~0u, __builtin_amdgcn_mbcnt_lo(~0u, 0u)); asm volatile("" : "+v"(lane_));
        int tid = wave0 * 64 + lane_;
        unsigned char* ws = ka->ws; asm volatile("" : "+s"(ws));
        int wave = wave0, bx = (int)blockIdx.x; asm volatile("" : "+s"(wave), "+s"(bx));
        const int lane = lane_ & 63;
        float* SS = (float*)(ws + WS_SS);
        float *ssx = SS, *ssh1 = SS + 16384, *ssA = SS + 2 * 16384, *ssB = SS + 3 * 16384, *ssh2 = SS + 4 * 16384, *ssh3 = SS + 5 * 16384;
        bf16_t* HB = (bf16_t*)(ws + WS_HB); bf16_t* Y = (bf16_t*)(ws + WS_Y); bf16_t* ACT = (bf16_t*)(ws + WS_ACT);
        const int G = gridDim.x, gw = bx * NWAVES + wave, NGW = G * NWAVES;
        if (ph == 0) {
            p0_prologue(ka, ws, lds, wave, lane, bx);
        } else if (ph == 1 || ph == 8) {
            const bool f1 = (ph == 1);
            pg8::Gemm g{HB, (const bf16_t*)(ws + (f1 ? WS_W1I : WS_W2I)), M, 2 * FF, D}; pg8::StaticOrder S; S.init(M, 2 * FF, G, bx);
            pg8::EpiSwiGLU E{f1 ? ssx : ssh2, ACT, FF};
#if !defined(NO_GEMM) && !defined(NO_G1)
            pg8::gemm_phase<pg8::EpiSwiGLU, pg8::StaticOrder, true, true>(lds, g, S, E, tid);
#endif
        } else if (ph == 2 || ph == 9) {
            const bf16_t* Bt = (const bf16_t*)(ws + (ph == 2 ? WS_W1O : WS_W2O));
            pg8::Gemm g{ACT, Bt, M, D, FF}; pg8::StaticOrder S; S.init(M, D, G, bx);
            pg8::EpiResid<false> E{ph == 2 ? ka->in[0] : (const float*)nullptr, HB, ph == 2 ? ssh1 : ssh3, 0.5f, nullptr, nullptr};
            pg8::gemm_phase<pg8::EpiResid<false>, pg8::StaticOrder, true, true>(lds, g, S, E, tid);
        } else if (ph == 7) {
            pg8::Gemm g{Y, (const bf16_t*)(ws + WS_WMO), M, D, D}; pg8::StaticOrder S; S.init(M, D, G, bx);
            pg8::EpiResid<true> E{(const float*)nullptr, HB, ssh2, 1.0f, ssA, ssB};
            pg8::gemm_phase<pg8::EpiResid<true>, pg8::StaticOrder, true, true>(lds, g, S, E, tid);
        } else if (ph == 3) {
            { pg8::Gemm g{HB, (const bf16_t*)(ws + WS_WMI), M, 4096, D}; pg8::StaticOrder S; S.init(M, 4096, G, bx);
              pg8::EpiProj E{ssh1, ACT};
#if !defined(NO_GEMM) && !defined(NO_G3)
              pg8::gemm_phase<pg8::EpiProj, pg8::StaticOrder, true, true>(lds, g, S, E, tid);
#endif
            }
            { pg8::Gemm g{(const bf16_t*)(ws + WS_WMI) + (size_t)4096 * D, HB, 1024, M, D}; pg8::StaticOrder S; S.init(1024, M, G, bx);
              pg8::EpiVT E{ssh1, ACT + 4 * (size_t)M * LW};
#if !defined(NO_GEMM) && !defined(NO_G4)
              pg8::gemm_phase<pg8::EpiVT, pg8::StaticOrder, true, true>(lds, g, S, E, tid);
#endif
            }
        } else if (ph == 4 || ph == 5) {
            const size_t SEG = (size_t)M * LW;
            LruCtx C{ACT, ACT + SEG, ka->in[6], ka->in[7], (const u32x4*)(ws + WS_GWP), ka->in[9], (const float*)(ws + WS_SP8), (float*)(ws + WS_AGG), (float*)(ws + WS_AGG + 2 * MiB), Y, ssA};
            lru_stage_consts(C, lds, bx & 15, tid);
            if (ph == 4) {
                { LAS float* tab = (LAS float*)(lds + L_RPB); const float* rpb = ka->in[11];
                  for (int i = tid; i < 16 * 15 * 32; i += NWAVES * 64) { const int rw = i >> 5, c = i & 31; tab[i] = c < 31 ? 1.44269504089f * gld<float>(rpb + rw * 31 + c) : 0.f; } }
                __syncthreads();
                for (int step = 0; step < 2; ++step) {
                    const bool do_lru = (step == 0) == (wave < 4);
                    int lane_s = lane; asm volatile("" : "+v"(lane_s));
                    if (do_lru) { lru_phase<1>(C, lds, wave, lane_s, G, bx); }
                    else {
                        AttnCtx A{ACT + 2 * SEG, ACT + 3 * SEG, ACT + 4 * SEG, (const LAS float*)(lds + L_RPB), Y, ssB};
                        if (G == 256) {
                            for (int i = 0; i < 8; ++i) attn_unit(A, ((bx & 7) << 11) | (i * 256 + (bx >> 3) * 8 + wave), lane_s);
                        } else { for (int u = gw; u < 16384; u += NGW) attn_unit(A, u, lane_s); }
                    }
                    asm volatile("" : "+v"(tid));
                }
            } else {
                __syncthreads();
                lru_phase<2>(C, lds, wave, lane, G, bx);
            }
            __syncthreads();
        } else if (ph == 6) {
        } else {
            const float* gF = ka->in[18];
            const f32x4* gr = (const f32x4*)gF + lane;
            for (int m0 = gw; m0 < M; m0 += 4 * NGW) {
                int mr[4]; float ss[4]; u32x2 r[4][8];
#pragma unroll
                for (int q = 0; q < 4; ++q) { mr[q] = (m0 + q * NGW < M) ? m0 + q * NGW : m0; ss[q] = gld<float>(ssh3 + mr[q]); }
#pragma unroll
                for (int q = 0; q < 4; ++q)
#pragma unroll
                    for (int j = 0; j < 8; ++j) r[q][j] = gld_nt<u32x2>((const u32x2*)(HB + (size_t)mr[q] * D) + lane + 64 * j);
#pragma unroll
                for (int j = 0; j < 8; ++j) { const f32x4 g = gld<f32x4>(gr + 64 * j);
#pragma unroll
                    for (int q = 0; q < 4; ++q) if (q == 0 || mr[q] != m0) {
                        const float rs = pg8::rstd_of(ss[q], 1.0f / 2048.0f);
                        gst_nt<f32x4>((f32x4*)(ka->out + (size_t)mr[q] * D) + lane + 64 * j, (f32x4){bf_lo(r[q][j].x), bf_hi(r[q][j].x), bf_lo(r[q][j].y), bf_hi(r[q][j].y)} * g * rs); }
                }
            }
        }
        if (ph + 1 < ph_hi && ph != 6) {
            if (coop == 1) xcd_barrier(bar, tid);
            else if (coop == 2) cg::this_grid().sync();
        }
    }
}

extern "C" void kernel_launch(void* const* d_in, const int* in_sizes, int n_in, void* d_out, int out_size, void* d_ws, size_t ws_size, hipStream_t stream) {
    static int grid = 0;
    if (grid == 0) {
        if (n_in != 19 || out_size != M * D || ws_size < WS_END) { fprintf(stderr, "kernel_launch: unexpected shapes (n_in %d, out %d, ws %zu)\n", n_in, out_size, ws_size); grid = -1; return; }
        int dev = 0, cus = 0, per_cu = 0;
        hipGetDevice(&dev); hipDeviceGetAttribute(&cus, hipDeviceAttributeMultiprocessorCount, dev);
        if (hipFuncSetAttribute((const void*)mk_fwd, hipFuncAttributeMaxDynamicSharedMemorySize, LDS_BYTES) != hipSuccess) { fprintf(stderr, "kernel_launch: hipFuncSetAttribute failed\n"); grid = -1; return; }
        if (hipOccupancyMaxActiveBlocksPerMultiprocessor(&per_cu, (const void*)mk_fwd, NWAVES * 64, LDS_BYTES) != hipSuccess || per_cu < 1) { fprintf(stderr, "kernel_launch: occupancy query says %d\n", per_cu); per_cu = 1; }
        (void)hipGetLastError();
        grid = cus * 1;
        if (grid != 256) fprintf(stderr, "kernel_launch: note: grid %d\n", grid);
    }
    if (grid < 0) return;
    Args a{};
    for (int i = 0; i < 19; ++i) a.in[i] = (const float*)d_in[i];
    a.out = (float*)d_out; a.ws = (unsigned char*)d_ws;
#if MK_COOP
    if (hipMemsetAsync((char*)d_ws + WS_BAR, 0, 16384, stream) != hipSuccess) { fprintf(stderr, "kernel_launch: memset of the barrier words failed\n"); return; }
    a.ph_lo = 0; a.ph_hi = N_PHASES; a.coop = 1;
    void* kargs[] = {&a};
    hipError_t e = hipLaunchCooperativeKernel((const void*)mk_fwd, dim3(grid), dim3(NWAVES * 64), kargs, LDS_BYTES, stream);
    if (e != hipSuccess) fprintf(stderr, "kernel_launch: cooperative launch failed: %s\n", hipGetErrorString(e));
#else
    for (int ph = 0; ph < N_PHASES; ++ph) {
        a.ph_lo = ph; a.ph_hi = ph + 1; a.coop = 0;
        hipLaunchKernelGGL(mk_fwd, dim3(grid), dim3(NWAVES * 64), LDS_BYTES, stream, a);
    }
#endif
}
```

```cpp
#include <hip/hip_runtime.h>
#include <hip/hip_cooperative_groups.h>
#include <cstdio>
#include <cstdint>
#include <cmath>
namespace cg = cooperative_groups;
namespace pg8 {
#define PG8_LAS __attribute__((address_space(3)))
typedef unsigned short bf16_t;
typedef short bf16x8 __attribute__((ext_vector_type(8)));
typedef float f32x4 __attribute__((ext_vector_type(4)));
typedef unsigned u32x4 __attribute__((ext_vector_type(4)));
constexpr int BM = 256, BK = 64, HALF = 128, HTB = HALF * BK * 2  , STAGE_BYTES = 8 * HTB, NXCD = 8, WGM = 8;

__host__ __device__ __forceinline__ int lds_byte(int r, int c) { const int st = (r >> 4) * 2 + (c >> 5), rr = r & 15, cc = c & 31, ob = rr * 64 + cc * 2; return st * 1024 + (ob ^ (((ob >> 9) & 1) << 5)); }
__host__ __device__ __forceinline__ void stage_rc(int b, int& R, int& C) { const int st = b / 1024, sb = b % 1024, swz = sb ^ (((sb >> 9) & 1) << 5); R = (st >> 1) * 16 + swz / 64; C = (st & 1) * 32 + (swz % 64) / 2; }
__host__ __device__ __forceinline__ int perm32(int rho) { const int n = rho >> 4, i = rho & 15; return 8 * (i >> 2) + 4 * n + (i & 3); }

struct Unit { int pm, pn; };
struct Gemm { const bf16_t* A; const bf16_t* Bt; int M, N, K; };

struct StaticOrder {
    int nM, nN, nwg, G, c;
    __host__ __device__ void init(int M, int N, int G_, int c_) { nM = M / BM; nN = N / BM; nwg = nM * nN; G = G_; c = c_; }
    __host__ __device__ bool next(int i, Unit& u) const {
        const long L = (long)i * G + c; if (L >= nwg) return false;
        int wgid = (int)L; { const int q = nwg / NXCD, r = nwg % NXCD, xcd = wgid % NXCD, off = wgid / NXCD; wgid = (xcd < r ? xcd * (q + 1) : r * (q + 1) + (xcd - r) * q) + off; }
        const int nig = WGM * nN, gid = wgid / nig, fm = gid * WGM, gsz = (nM - fm) < WGM ? (nM - fm) : WGM;
        u.pm = fm + ((wgid % nig) % gsz); u.pn = (wgid % nig) / gsz; return true;
    }
    __device__ __forceinline__ void a_ready(const Unit&) const {}
    __device__ __forceinline__ void done(const Unit&) const {}
};

__device__ __forceinline__ unsigned cvt_pk_bf16(float lo, float hi) { unsigned r; asm volatile("v_cvt_pk_bf16_f32 %0, %1, %2" : "=v"(r) : "v"(lo), "v"(hi)); return r; }
typedef float f32x2 __attribute__((ext_vector_type(2)));
#define GAS __attribute__((address_space(1)))
template <class T> __device__ __forceinline__ T gld(const void* p) { return *(const GAS T*)p; }
template <class T> __device__ __forceinline__ void gst(void* p, T v) { *(GAS T*)p = v; }
template <class T> __device__ __forceinline__ void gst_nt(void* p, T v) { __builtin_nontemporal_store(v, (GAS T*)p); }
template <class T> __device__ __forceinline__ T gld_nt(const void* p) { return __builtin_nontemporal_load((const GAS T*)p); }
__device__ __forceinline__ void gatomic_add(float* p, float v) { (void)__hip_atomic_fetch_add((GAS float*)p, v, __ATOMIC_RELAXED, __HIP_MEMORY_SCOPE_AGENT); }
typedef unsigned u32x2 __attribute__((ext_vector_type(2)));
constexpr float RMS_EPS = 1e-6f;
__device__ __forceinline__ float rstd_of(float ss, float inv_n) { return __builtin_amdgcn_rsqf(ss * inv_n + RMS_EPS); }
__device__ __forceinline__ float silu_f(float g) { return g * __builtin_amdgcn_rcpf(1.0f + __expf(-g)); }

struct EpiSwiGLU {
    static constexpr bool PERM = true, AFTER_DRAIN = false, HAS_MID = false;
    const float* ss; bf16_t* O; int ldo;
    __device__ __forceinline__ void mid(f32x4 (&)[2][2][4][2], const Unit&, int, int) const {}
    __device__ __forceinline__ void operator()(const f32x4 (&acc)[2][2][4][2], const Unit& u, int wr, int wc, int fr, int fq) const {
        const int row0 = u.pm * BM + wr * 64 + fr; const int col0 = u.pn * HALF + wc * 32 + 8 * fq;
        float rsv[2][4];
#pragma unroll
        for (int ai = 0; ai < 2; ++ai)
#pragma unroll
            for (int m = 0; m < 4; ++m) rsv[ai][m] = gld<float>(ss + row0 + ai * HALF + m * 16);
        __builtin_amdgcn_sched_barrier(0);
#pragma unroll
        for (int ai = 0; ai < 2; ++ai)
#pragma unroll
            for (int m = 0; m < 4; ++m) {
                const int row = row0 + ai * HALF + m * 16;
                const float rs = rstd_of(rsv[ai][m], 1.0f / 2048.0f);
                float v[8];
                const float cneg = rs * -1.44269504089f, rs2 = rs * rs;
#pragma unroll
                for (int n = 0; n < 2; ++n)
#pragma unroll
                    for (int hh = 0; hh < 2; ++hh) {
                        const f32x2 g = (f32x2){acc[ai][0][m][n][2 * hh], acc[ai][0][m][n][2 * hh + 1]}, up = (f32x2){acc[ai][1][m][n][2 * hh], acc[ai][1][m][n][2 * hh + 1]};
                        const f32x2 t = g * cneg;
                        f32x2 d; d.x = __builtin_amdgcn_exp2f(t.x); d.y = __builtin_amdgcn_exp2f(t.y); d = d + 1.0f;
                        f32x2 r; r.x = __builtin_amdgcn_rcpf(d.x); r.y = __builtin_amdgcn_rcpf(d.y);
                        const f32x2 o = (g * up) * (r * rs2);
                        v[n * 4 + 2 * hh] = o.x; v[n * 4 + 2 * hh + 1] = o.y;
                    }
                u32x4 w; w.x = cvt_pk_bf16(v[0], v[1]); w.y = cvt_pk_bf16(v[2], v[3]); w.z = cvt_pk_bf16(v[4], v[5]); w.w = cvt_pk_bf16(v[6], v[7]);
                gst<u32x4>(O + (size_t)row * ldo + col0, w);
            }
    }
};

struct EpiProj {
    static constexpr bool PERM = true, AFTER_DRAIN = false, HAS_MID = false;
    const float* ss; bf16_t* base;
    __device__ __forceinline__ void mid(f32x4 (&)[2][2][4][2], const Unit&, int, int) const {}
    __device__ __forceinline__ void operator()(const f32x4 (&acc)[2][2][4][2], const Unit& u, int wr, int wc, int fr, int fq) const {
        const int seg = u.pn >> 2; const int colt = (u.pn & 3) * BM + wc * 32 + 8 * fq;
        const int row0 = u.pm * BM + wr * 64 + fr;
        const float qs = (seg == 2) ? 0.125f * 1.44269504089f : 1.0f;
        bf16_t* op = base + (size_t)seg * ((size_t)16384 * 1024) + (size_t)row0 * 1024 + colt;
        float rsv[2][4];
#pragma unroll
        for (int ai = 0; ai < 2; ++ai)
#pragma unroll
            for (int m = 0; m < 4; ++m) rsv[ai][m] = gld<float>(ss + row0 + ai * HALF + m * 16);
        __builtin_amdgcn_sched_barrier(0);
        const int kb_b = (u.pm * BM) >> 11, kb_s0 = row0 & 2047;
#pragma unroll
        for (int ai = 0; ai < 2; ++ai)
#pragma unroll
            for (int m = 0; m < 4; ++m) {
                const float rs = rstd_of(rsv[ai][m], 1.0f / 2048.0f) * qs;
#pragma unroll
                for (int bj = 0; bj < 2; ++bj) {
                    const f32x4 v0 = acc[ai][bj][m][0] * rs, v1 = acc[ai][bj][m][1] * rs;
                    u32x4 w; w.x = cvt_pk_bf16(v0[0], v0[1]); w.y = cvt_pk_bf16(v0[2], v0[3]); w.z = cvt_pk_bf16(v1[0], v1[1]); w.w = cvt_pk_bf16(v1[2], v1[3]);
                    if (seg == 3) { const int col = colt + bj * HALF, s = kb_s0 + ai * HALF + m * 16;
                        gst<u32x4>(base + (size_t)3 * ((size_t)16384 * 1024) + ((((size_t)(kb_b * 16 + (col >> 6))) * 2 + ((col >> 5) & 1)) * 2048 + s) * 32 + (col & 31), w); }
                    else gst<u32x4>(op + (size_t)(ai * HALF + m * 16) * 1024 + bj * HALF, w);
                }
                asm volatile("" ::: "memory");
            }
    }
};
struct EpiVT {
    static constexpr bool PERM = true, AFTER_DRAIN = false, HAS_MID = false;
    const float* ss; bf16_t* vT;
    __device__ __forceinline__ void mid(f32x4 (&)[2][2][4][2], const Unit&, int, int) const {}
    __device__ __forceinline__ void operator()(const f32x4 (&acc)[2][2][4][2], const Unit& u, int wr, int wc, int fr, int fq) const {
        const int tok0 = u.pn * BM + wc * 32 + 8 * fq;
        const int b = tok0 >> 11, s0 = tok0 & 2047;
#pragma unroll
        for (int bj = 0; bj < 2; ++bj) {
            const f32x4 s_lo = gld<f32x4>(ss + tok0 + bj * HALF), s_hi = gld<f32x4>(ss + tok0 + bj * HALF + 4);
            float rs[8];
#pragma unroll
            for (int e = 0; e < 4; ++e) { rs[e] = rstd_of(s_lo[e], 1.0f / 2048.0f); rs[4 + e] = rstd_of(s_hi[e], 1.0f / 2048.0f); }
#pragma unroll
            for (int ai = 0; ai < 2; ++ai)
#pragma unroll
                for (int m = 0; m < 4; ++m) {
                    const f32x4 v0 = acc[ai][bj][m][0], v1 = acc[ai][bj][m][1];
                    u32x4 w; w.x = cvt_pk_bf16(v0[0] * rs[0], v0[1] * rs[1]); w.y = cvt_pk_bf16(v0[2] * rs[2], v0[3] * rs[3]); w.z = cvt_pk_bf16(v1[0] * rs[4], v1[1] * rs[5]); w.w = cvt_pk_bf16(v1[2] * rs[6], v1[3] * rs[7]);
                    { const int hh = 4 * u.pm + wr + 2 * ai, dd = 16 * m + fr, s = s0 + bj * HALF;
                      gst<u32x4>(vT + ((((size_t)((b * 16 + hh) * 32 + (s >> 6))) * 8 + ((s >> 3) & 7)) * 64 + dd) * 8, w); }
                }
            asm volatile("" ::: "memory");
        }
    }
};

template <bool MIX> struct EpiResid {
    static constexpr bool PERM = true, AFTER_DRAIN = false, HAS_MID = MIX;
    const float* resid_f; bf16_t* hb; float* ss_out; float alpha; const float* ssA; const float* ssB;
    __device__ __forceinline__ void mid(f32x4 (&acc)[2][2][4][2], const Unit& u, int wr, int fr) const {
        if constexpr (MIX) {
            const int row0 = u.pm * BM + wr * 64 + fr;
            float sa[2][4], sb[2][4];
#pragma unroll
            for (int ai = 0; ai < 2; ++ai)
#pragma unroll
                for (int m = 0; m < 4; ++m) { sa[ai][m] = gld<float>(ssA + row0 + ai * HALF + m * 16); sb[ai][m] = gld<float>(ssB + row0 + ai * HALF + m * 16); }
#pragma unroll
            for (int ai = 0; ai < 2; ++ai)
#pragma unroll
                for (int m = 0; m < 4; ++m) {
                    const float f = rstd_of(sa[ai][m], 1.0f / 1024.0f) * __builtin_amdgcn_rcpf(rstd_of(sb[ai][m], 1.0f / 1024.0f));
#pragma unroll
                    for (int bj = 0; bj < 2; ++bj)
#pragma unroll
                        for (int n = 0; n < 2; ++n) acc[ai][bj][m][n] = acc[ai][bj][m][n] * f;
                }
        }
    }
    __device__ __forceinline__ void operator()(const f32x4 (&acc)[2][2][4][2], const Unit& u, int wr, int wc, int fr, int fq) const {
        const int row0 = u.pm * BM + wr * 64 + fr; const int col0 = u.pn * BM + wc * 32 + 8 * fq;
#pragma unroll
        for (int ai = 0; ai < 2; ++ai) {
            float sbv[4] = {0.f, 0.f, 0.f, 0.f};
            if constexpr (MIX) {
#pragma unroll
                for (int m = 0; m < 4; ++m) sbv[m] = gld<float>(ssB + row0 + ai * HALF + m * 16);
            }
            f32x4 pre[4][2][2];
            if (resid_f) {
#pragma unroll
                for (int m = 0; m < 4; ++m) { const size_t off = (size_t)(row0 + ai * HALF + m * 16) * 2048 + col0;
#pragma unroll
                    for (int bj = 0; bj < 2; ++bj)
#pragma unroll
                        for (int n = 0; n < 2; ++n) pre[m][bj][n] = gld_nt<f32x4>(resid_f + off + bj * HALF + n * 4); }
            } else {
                u32x4 raw[4][2];
#pragma unroll
                for (int m = 0; m < 4; ++m) { const size_t off = (size_t)(row0 + ai * HALF + m * 16) * 2048 + col0;
#pragma unroll
                    for (int bj = 0; bj < 2; ++bj) raw[m][bj] = gld<u32x4>(hb + off + bj * HALF); }
                __builtin_amdgcn_sched_barrier(0);
#pragma unroll
                for (int m = 0; m < 4; ++m)
#pragma unroll
                    for (int bj = 0; bj < 2; ++bj) { const u32x4 r = raw[m][bj];
                        pre[m][bj][0] = (f32x4){__uint_as_float(r.x << 16), __uint_as_float(r.x & 0xffff0000u), __uint_as_float(r.y << 16), __uint_as_float(r.y & 0xffff0000u)};
                        pre[m][bj][1] = (f32x4){__uint_as_float(r.z << 16), __uint_as_float(r.z & 0xffff0000u), __uint_as_float(r.w << 16), __uint_as_float(r.w & 0xffff0000u)}; }
            }
            __builtin_amdgcn_sched_barrier(0);
#pragma unroll
            for (int m = 0; m < 4; ++m) {
                const int row = row0 + ai * HALF + m * 16;
                const size_t off = (size_t)row * 2048 + col0;
                float s2 = 0.f;
                const float sc = MIX ? rstd_of(sbv[m], 1.0f / 1024.0f) : alpha;
#pragma unroll
                for (int bj = 0; bj < 2; ++bj) {
                    const f32x4 o0 = pre[m][bj][0] + acc[ai][bj][m][0] * sc, o1 = pre[m][bj][1] + acc[ai][bj][m][1] * sc;
                    s2 += ((o0[0] * o0[0] + o0[1] * o0[1]) + (o0[2] * o0[2] + o0[3] * o0[3])) + ((o1[0] * o1[0] + o1[1] * o1[1]) + (o1[2] * o1[2] + o1[3] * o1[3]));
                    u32x4 w; w.x = cvt_pk_bf16(o0[0], o0[1]); w.y = cvt_pk_bf16(o0[2], o0[3]); w.z = cvt_pk_bf16(o1[0], o1[1]); w.w = cvt_pk_bf16(o1[2], o1[3]);
                    gst<u32x4>(hb + off + bj * HALF, w);
                }
                s2 += __shfl_xor(s2, 16); s2 += __shfl_xor(s2, 32);
                if (fq == 0) gatomic_add(ss_out + row, s2);
            }
            asm volatile("" ::: "memory");
        }
    }
};
template <class Epi, class Sched, bool ALIGN_EPI = false, bool SP2 = false>
__device__ __forceinline__ void gemm_phase(PG8_LAS unsigned char* lds, const Gemm g, const Sched& S, const Epi& E, int tid_in) {
    int tid_ = tid_in; asm volatile("" : "+v"(tid_));
    const int tid = tid_, wid = __builtin_amdgcn_readfirstlane(tid >> 6), lane = tid & 63, wr = wid >> 2, wc = wid & 3, fr = lane & 15, fq = lane >> 4;
    const int K = g.K, nt = K / BK;
    unsigned voffA[2], voffB[2];
#pragma unroll
    for (int i = 0; i < 2; ++i) { int R, C; stage_rc(tid * 16 + i * 8192, R, C); const int Rb = Epi::PERM ? ((R & ~31) + perm32(R & 31)) : R;
        voffA[i] = (unsigned)(R * K + C) * 2u; voffB[i] = (unsigned)(Rb * K + C) * 2u; }
    const size_t kstep = (size_t)(BK * 2);
    const size_t hstep = (size_t)HALF * K * 2;
    const size_t tstep = 2 * hstep;
    const unsigned ldsw = (unsigned)wid * 1024u;
    const int aoff = lds_byte(wr * 64 + fr, fq * 8), boff = lds_byte(wc * 32 + fr, fq * 8);
#define PG8_SA(b, h) (((b) * 2 + (h)) * HTB)
#define PG8_SB(b, h) ((4 + (b) * 2 + (h)) * HTB)
#define PG8_STAGE(bufoff, gbase, voff) do { _Pragma("unroll") for (int _i = 0; _i < 2; ++_i) \
        __builtin_amdgcn_global_load_lds((const unsigned*)((const char*)(gbase) + (voff)[_i]), (PG8_LAS unsigned*)(lds + (bufoff) + ldsw + _i * 8192), 16, 0, 0); } while (0)
#define PG8_LDA(dst, b, h) do { _Pragma("unroll") for (int m = 0; m < 4; ++m) _Pragma("unroll") for (int k = 0; k < 2; ++k) dst[m][k] = *(const PG8_LAS bf16x8*)(lds + PG8_SA(b, h) + aoff + m * 2048 + k * 1024); } while (0)
#define PG8_LDB(dst, b, h) do { _Pragma("unroll") for (int n = 0; n < 2; ++n) _Pragma("unroll") for (int k = 0; k < 2; ++k) dst[n][k] = *(const PG8_LAS bf16x8*)(lds + PG8_SB(b, h) + boff + n * 2048 + k * 1024); } while (0)
#define PG8_MMA(ai, bj, At, Bt) do { __builtin_amdgcn_s_setprio(1); _Pragma("unroll") for (int m = 0; m < 4; ++m) _Pragma("unroll") for (int n = 0; n < 2; ++n) _Pragma("unroll") for (int k = 0; k < 2; ++k) \
        acc[ai][bj][m][n] = __builtin_amdgcn_mfma_f32_16x16x32_bf16(Bt[n][k], At[m][k], acc[ai][bj][m][n], 0, 0, 0); __builtin_amdgcn_s_setprio(0); } while (0)
#define PG8_WAIT_V(n) asm volatile("s_waitcnt vmcnt(" #n ")" ::: "memory")
#define PG8_WAIT_L(n) asm volatile("s_waitcnt lgkmcnt(" #n ")" ::: "memory")
#define PG8_BAR __builtin_amdgcn_s_barrier()
#define PG8_SCHED __builtin_amdgcn_sched_barrier(0)
    Unit cur, nxt; int ui = 0;
    if (!S.next(0, cur)) return;
    f32x4 acc[2][2][4][2];
#pragma unroll
    for (int a = 0; a < 2; ++a)
#pragma unroll
        for (int b = 0; b < 2; ++b)
#pragma unroll
            for (int m = 0; m < 4; ++m)
#pragma unroll
                for (int n = 0; n < 2; ++n) acc[a][b][m][n] = (f32x4){0.f, 0.f, 0.f, 0.f};
    bf16x8 At[4][2], B0[2][2], B1[2][2];
    const char* cA = (const char*)g.A + (size_t)cur.pm * tstep; const char* cB = (const char*)g.Bt + (size_t)cur.pn * tstep;
    S.a_ready(cur);
    if constexpr (SP2) {
        PG8_STAGE(PG8_SB(0, 0), cB, voffB); PG8_STAGE(PG8_SB(0, 1), cB + hstep, voffB); PG8_STAGE(PG8_SA(0, 0), cA, voffA); PG8_STAGE(PG8_SA(0, 1), cA + hstep, voffA);
        if (wr == 1) PG8_BAR;
        PG8_WAIT_V(2); PG8_BAR;
        PG8_STAGE(PG8_SB(1, 0), cB + kstep, voffB); PG8_STAGE(PG8_SA(1, 0), cA + kstep, voffA); PG8_STAGE(PG8_SB(1, 1), cB + hstep + kstep, voffB);
        PG8_WAIT_V(6); PG8_BAR;
    } else {
        PG8_STAGE(PG8_SB(0, 0), cB, voffB); PG8_STAGE(PG8_SA(0, 0), cA, voffA); PG8_STAGE(PG8_SB(0, 1), cB + hstep, voffB); PG8_STAGE(PG8_SA(0, 1), cA + hstep, voffA);
        if (wr == 1) PG8_BAR;
        PG8_WAIT_V(4); PG8_BAR;
        PG8_STAGE(PG8_SB(1, 0), cB + kstep, voffB); PG8_STAGE(PG8_SA(1, 0), cA + kstep, voffA); PG8_STAGE(PG8_SB(1, 1), cB + hstep + kstep, voffB);
        PG8_WAIT_V(6); PG8_BAR;
    }
    for (;;) {
        const bool has_next = S.next(ui + 1, nxt);
        const char* nA = has_next ? (const char*)g.A + (size_t)nxt.pm * tstep : cA; const char* nB = has_next ? (const char*)g.Bt + (size_t)nxt.pn * tstep : cB;
        constexpr int NHK = Epi::HAS_MID ? 2 : 1;
#pragma unroll
        for (int hk = 0; hk < NHK; ++hk) {
        if constexpr (Epi::HAS_MID) { if (hk == 1) E.mid(acc, cur, wr, fr); }
        const int t_beg = hk * (nt / NHK), t_end = (hk + 1) * (nt / NHK);
        for (int t = t_beg; t < t_end; t += 2) {
            const bool last = (t == nt - 2);
            const char* a1 = cA + (size_t)(t + 1) * kstep;
            const char* a2 = last ? nA : cA + (size_t)(t + 2) * kstep; const char* b2 = last ? nB : cB + (size_t)(t + 2) * kstep;
            const char* a3 = a2 + kstep; const char* b3 = b2 + kstep;
            if (last && has_next) S.a_ready(nxt);
            if constexpr (SP2) {
            PG8_LDB(B0, 0, 0); PG8_LDB(B1, 0, 1); PG8_SCHED; PG8_LDA(At, 0, 0); PG8_STAGE(PG8_SA(1, 1), a1 + hstep, voffA);
            PG8_WAIT_V(8); PG8_WAIT_L(0); PG8_BAR; PG8_MMA(0, 0, At, B0); PG8_MMA(0, 1, At, B1); PG8_BAR; PG8_SCHED;
            PG8_LDA(At, 0, 1); PG8_STAGE(PG8_SB(0, 0), b2, voffB); PG8_STAGE(PG8_SB(0, 1), b2 + hstep, voffB); PG8_STAGE(PG8_SA(0, 0), a2, voffA);
            PG8_WAIT_V(8); PG8_WAIT_L(0); PG8_BAR; PG8_MMA(1, 0, At, B0); PG8_MMA(1, 1, At, B1); PG8_BAR; PG8_SCHED;
            PG8_LDB(B0, 1, 0); PG8_LDB(B1, 1, 1); PG8_SCHED; PG8_LDA(At, 1, 0); PG8_STAGE(PG8_SA(0, 1), a2 + hstep, voffA);
            PG8_WAIT_V(8); PG8_WAIT_L(0); PG8_BAR; PG8_MMA(0, 0, At, B0); PG8_MMA(0, 1, At, B1); PG8_BAR; PG8_SCHED;
            PG8_LDA(At, 1, 1); PG8_STAGE(PG8_SB(1, 0), b3, voffB); PG8_STAGE(PG8_SB(1, 1), b3 + hstep, voffB); PG8_STAGE(PG8_SA(1, 0), a3, voffA);
            PG8_WAIT_V(8); PG8_WAIT_L(0); PG8_BAR; PG8_MMA(1, 0, At, B0); PG8_MMA(1, 1, At, B1); PG8_BAR; PG8_SCHED;
            } else {
            PG8_LDB(B0, 0, 0); PG8_SCHED; PG8_LDA(At, 0, 0); PG8_STAGE(PG8_SA(1, 1), a1 + hstep, voffA);
            PG8_WAIT_L(8); PG8_BAR; PG8_WAIT_L(0); PG8_MMA(0, 0, At, B0); PG8_BAR; PG8_SCHED;
            PG8_LDB(B1, 0, 1); PG8_STAGE(PG8_SB(0, 0), b2, voffB);
            PG8_BAR; PG8_WAIT_L(0); PG8_MMA(0, 1, At, B1); PG8_BAR;
            PG8_LDA(At, 0, 1); PG8_STAGE(PG8_SA(0, 0), a2, voffA);
            PG8_BAR; PG8_WAIT_L(0); PG8_MMA(1, 0, At, B0); PG8_BAR; PG8_SCHED;
            PG8_STAGE(PG8_SB(0, 1), b2 + hstep, voffB);
            PG8_WAIT_V(6); PG8_BAR; PG8_MMA(1, 1, At, B1); PG8_BAR;
            PG8_LDB(B0, 1, 0); PG8_SCHED; PG8_LDA(At, 1, 0); PG8_STAGE(PG8_SA(0, 1), a2 + hstep, voffA);
            PG8_WAIT_L(8); PG8_BAR; PG8_WAIT_L(0); PG8_MMA(0, 0, At, B0); PG8_BAR; PG8_SCHED;
            PG8_LDB(B1, 1, 1); PG8_STAGE(PG8_SB(1, 0), b3, voffB);
            PG8_BAR; PG8_WAIT_L(0); PG8_MMA(0, 1, At, B1); PG8_BAR;
            PG8_LDA(At, 1, 1); PG8_STAGE(PG8_SA(1, 0), a3, voffA);
            PG8_BAR; PG8_WAIT_L(0); PG8_MMA(1, 0, At, B0); PG8_BAR; PG8_SCHED;
            PG8_STAGE(PG8_SB(1, 1), b3 + hstep, voffB);
            PG8_WAIT_V(6); PG8_BAR; PG8_MMA(1, 1, At, B1); PG8_BAR;
            }
        }
        }
        if constexpr (ALIGN_EPI) { if (wr == 0) PG8_BAR; }
        if constexpr (!Epi::AFTER_DRAIN) { E(acc, cur, wr, wc, fr, fq); S.done(cur); }
        if (!has_next) break;
#pragma unroll
        for (int a = 0; a < 2; ++a)
#pragma unroll
            for (int b = 0; b < 2; ++b)
#pragma unroll
                for (int m = 0; m < 4; ++m)
#pragma unroll
                    for (int n = 0; n < 2; ++n) acc[a][b][m][n] = (f32x4){0.f, 0.f, 0.f, 0.f};
        cur = nxt; cA = nA; cB = nB; ++ui;
        if constexpr (ALIGN_EPI) { if (wr == 1) PG8_BAR; }
    }
    PG8_WAIT_V(0);
    if constexpr (!ALIGN_EPI) { if (wr == 0) PG8_BAR; }
    PG8_BAR;
    if constexpr (Epi::AFTER_DRAIN) { E.fused(acc, cur, wr, wc, fr, fq, lds, wid, lane); S.done(cur); }
#undef PG8_SA
#undef PG8_SB
#undef PG8_STAGE
#undef PG8_LDA
#undef PG8_LDB
#undef PG8_MMA
#undef PG8_WAIT_V
#undef PG8_WAIT_L
#undef PG8_BAR
#undef PG8_SCHED
}
}
constexpr int NWAVES = 8;
constexpr int M = 16384, D = 2048, FF = 5632, SEQ = 2048, NB = 8, LW = 1024;
constexpr int N_PHASES = 11;
#ifndef MK_COOP
#define MK_COOP 1
#endif
constexpr size_t MiB = 1u << 20;
constexpr size_t WS_SS = 0;
constexpr size_t WS_SP8 = 6 * 65536;
constexpr size_t WS_BAR = 768 * 1024;
constexpr size_t WS_GWP = 1 * MiB;
constexpr size_t WS_AGG = 2 * MiB;
constexpr size_t WS_W1I = 8 * MiB, WS_W1O = 52 * MiB, WS_WMI = 74 * MiB, WS_WMO = 94 * MiB, WS_W2I = 102 * MiB, WS_W2O = 146 * MiB;
constexpr size_t WS_HB = 168 * MiB;
constexpr size_t WS_Y = 232 * MiB;
constexpr size_t WS_ACT = 296 * MiB;
constexpr size_t WS_END = 472 * MiB;

#define LAS __attribute__((address_space(3)))
using pg8::gld; using pg8::gld_nt; using pg8::gst; using pg8::gst_nt; using pg8::gatomic_add;
typedef unsigned short bf16_t;
typedef short bf16x8 __attribute__((ext_vector_type(8)));
typedef float f32x4 __attribute__((ext_vector_type(4)));
typedef unsigned u32x4 __attribute__((ext_vector_type(4)));
typedef unsigned u32x2 __attribute__((ext_vector_type(2)));
constexpr int RING_BYTES = 131072;
constexpr int LDS_BYTES = 163840;
constexpr int L_BARST = LDS_BYTES - 64;

#define LDS_WAIT() asm volatile("s_waitcnt lgkmcnt(0)" ::: "memory")
#define SCHED_FENCE() __builtin_amdgcn_sched_barrier(0)
__device__ __forceinline__ unsigned pk2(float lo, float hi) { return pg8::cvt_pk_bf16(lo, hi); }
__device__ __forceinline__ float bf_lo(unsigned w) { return __uint_as_float(w << 16); }
__device__ __forceinline__ float bf_hi(unsigned w) { return __uint_as_float(w & 0xffff0000u); }
__device__ __forceinline__ float wave_sum(float v) {
#pragma unroll
    for (int o = 1; o < 64; o <<= 1) v += __shfl_xor(v, o);
    return v;
}
__device__ __forceinline__ bf16x8 mk8(float a0, float a1, float a2, float a3, float a4, float a5, float a6, float a7) {
    u32x4 w; w.x = pk2(a0, a1); w.y = pk2(a2, a3); w.z = pk2(a4, a5); w.w = pk2(a6, a7);
    return __builtin_bit_cast(bf16x8, w);
}
#define MFMA16(x, y, c) __builtin_amdgcn_mfma_f32_16x16x32_bf16((x), (y), (c), 0, 0, 0)

#define XB_TMO      128
#define XB_XCNT(j)  (256  + 64 * (j))
#define XB_XSUB(j)  (1280 + 64 * (j))
#define XB_XGEN(j)  (2304 + 64 * (j))
#define XB_TOP      3328
#define XB_TOPGEN   3392
#define XCD_BAR_WORDS 3456
#define XB_SPIN_CAP (1u << 18)

__device__ __forceinline__ unsigned xb_ld(unsigned* p)              { return __hip_atomic_load(p, __ATOMIC_RELAXED, __HIP_MEMORY_SCOPE_AGENT); }
__device__ __forceinline__ unsigned xb_add(unsigned* p, unsigned v) { return __hip_atomic_fetch_add(p, v, __ATOMIC_RELAXED, __HIP_MEMORY_SCOPE_AGENT); }
__device__ __forceinline__ unsigned xb_xcc_id() { return (unsigned)__builtin_amdgcn_s_getreg((3 << 11) | 20) & 0xFu; }
#define XB_SPIN(cond, bar) do { unsigned _sp = 0; while (cond) { __builtin_amdgcn_s_sleep(1); \
    if ((++_sp & 255u) == 0u) { if (xb_ld(&(bar)[XB_TMO])) break; if (_sp > XB_SPIN_CAP) { atomicAdd(&(bar)[XB_TMO], 1u); break; } } } } while (0)

struct XcdBarrier {
    unsigned* bar; unsigned x;
    volatile LAS unsigned* st;
};

__device__ __forceinline__ XcdBarrier xcd_barrier_post(unsigned* bar, volatile LAS unsigned* st, int tid) {
    XcdBarrier b; b.bar = bar; b.x = xb_xcc_id(); b.st = st;
    if (tid == 0) (void)xb_add(&bar[XB_XCNT(b.x)], 1u);
    return b;
}
__device__ __forceinline__ void xcd_barrier_complete(unsigned* bar, unsigned x, unsigned& nloc, unsigned& nx) {
    const unsigned G = gridDim.x * gridDim.y * gridDim.z;
    unsigned sum, cnt, mine, sp = 0u;
    for (;;) {
        sum = 0u; cnt = 0u; mine = 0u;
#pragma unroll
        for (unsigned j = 0; j < 16; ++j) { const unsigned c = xb_ld(&bar[XB_XCNT(j)]); sum += c; cnt += (c > 0u) ? 1u : 0u; mine = (j == x) ? c : mine; }
        if (sum == G) break;
        __builtin_amdgcn_s_sleep(1);
        if ((++sp & 255u) == 0u) { if (xb_ld(&bar[XB_TMO])) break; if (sp > XB_SPIN_CAP) { atomicAdd(&bar[XB_TMO], 1u); break; } }
    }
    nloc = mine > 0u ? mine : 1u; nx = cnt > 0u ? cnt : 1u;
}

__device__ __forceinline__ void xcd_barrier(const XcdBarrier& b, int tid) {
    asm volatile("s_waitcnt vmcnt(0)" ::: "memory");
    __syncthreads();
    if (tid == 0) {
        unsigned* bar = b.bar;
        __builtin_amdgcn_s_waitcnt(0);
        unsigned nloc = b.st[0], nx = b.st[1];
        if (nloc == 0u) { xcd_barrier_complete(bar, b.x, nloc, nx); b.st[0] = nloc; b.st[1] = nx; }
        const unsigned old = xb_add(&bar[XB_XSUB(b.x)], 1u);
        const unsigned gen = old / nloc;
        if (old + 1u == (gen + 1u) * nloc) {
            __builtin_amdgcn_fence(__ATOMIC_RELEASE, "agent");
            asm volatile("s_waitcnt vmcnt(0)" ::: "memory");
            const unsigned og = xb_add(&bar[XB_TOP], 1u);
            const unsigned tg = og / nx;
            if (og + 1u == (tg + 1u) * nx) xb_add(&bar[XB_TOPGEN], 1u);
            else XB_SPIN(xb_ld(&bar[XB_TOPGEN]) == tg, bar);
            __builtin_amdgcn_fence(__ATOMIC_ACQUIRE, "agent");
            xb_add(&bar[XB_XGEN(b.x)], 1u);
            asm volatile("s_waitcnt vmcnt(0)" ::: "memory");
        } else {
            XB_SPIN(xb_ld(&bar[XB_XGEN(b.x)]) == gen, bar);
            __builtin_amdgcn_fence(__ATOMIC_ACQUIRE, "agent");
            asm volatile("s_waitcnt vmcnt(0)" ::: "memory");
        }
    }
    __syncthreads();
}

struct Args { const float* in[19]; float* out; unsigned char* ws; int ph_lo, ph_hi, coop, pad; };
typedef const __attribute__((address_space(4))) Args* KArgs;

struct P0Item { const float* W; const float* gk; bf16_t* WT; int K, N, dest_row0, k0, n0; };
__device__ __forceinline__ int swiglu_dest(int n0) { return n0 < FF ? (n0 >> 7) * 256 + (n0 & 127) : ((n0 - FF) >> 7) * 256 + 128 + ((n0 - FF) & 127); }
__device__ __forceinline__ P0Item p0_decode(KArgs a, unsigned char* ws, int it) {
    constexpr int I_FI = (D / 64) * (2 * FF / 64), I_FO = (FF / 64) * (D / 64), I_MI = (D / 64) * (5120 / 64);
    int r = it; P0Item I;
    if (r < 2 * I_FI) { const bool f1 = r < I_FI; if (!f1) r -= I_FI; const int nblk = 2 * FF / 64, kb = r / nblk, nb = r % nblk;
        I.W = a->in[f1 ? 2 : 16]; I.gk = a->in[f1 ? 1 : 15] + 64 * kb; I.WT = (bf16_t*)(ws + (f1 ? WS_W1I : WS_W2I)); I.K = D; I.N = 2 * FF; I.dest_row0 = swiglu_dest(64 * nb); I.k0 = 64 * kb; I.n0 = 64 * nb; return I; }
    r -= 2 * I_FI;
    if (r < 2 * I_FO) { const bool f1 = r < I_FO; if (!f1) r -= I_FO; const int nblk = D / 64, kb = r / nblk, nb = r % nblk;
        I.W = a->in[f1 ? 3 : 17]; I.gk = nullptr; I.WT = (bf16_t*)(ws + (f1 ? WS_W1O : WS_W2O)); I.K = FF; I.N = D; I.dest_row0 = 64 * nb; I.k0 = 64 * kb; I.n0 = 64 * nb; return I; }
    r -= 2 * I_FO;
    if (r < I_MI) { const int nblk = 5120 / 64, kb = r / nblk, nb = r % nblk;
        I.W = a->in[5]; I.gk = a->in[4] + 64 * kb; I.WT = (bf16_t*)(ws + WS_WMI); I.K = D; I.N = 5120; I.dest_row0 = 64 * nb; I.k0 = 64 * kb; I.n0 = 64 * nb; return I; }
    r -= I_MI;
    { const int nblk = D / 64, kb = r / nblk, nb = r % nblk;
      I.W = a->in[14]; I.gk = (kb < 16) ? a->in[12] + 64 * kb : a->in[13] + 64 * (kb - 16); I.WT = (bf16_t*)(ws + WS_WMO); I.K = D; I.N = D; I.dest_row0 = 64 * nb; I.k0 = 64 * kb; I.n0 = 64 * nb; return I; }
}
__device__ __forceinline__ void p0_load(const P0Item& I, int lane, f32x4 (&v)[16], float (&g)[16]) {
    const int lr = lane >> 4, lc = (lane & 15) * 4;
#pragma unroll
    for (int i = 0; i < 16; ++i) { v[i] = gld_nt<f32x4>(I.W + (size_t)(I.k0 + 4 * i + lr) * I.N + I.n0 + lc); g[i] = I.gk ? gld<float>(I.gk + 4 * i + lr) : 1.0f; }
}
__device__ __forceinline__ void p0_finish(const P0Item& I, LAS float* scr, int lane, const f32x4 (&v)[16], const float (&g)[16]) {
    const int lr = lane >> 4, lc = (lane & 15) * 4;
#pragma unroll
    for (int i = 0; i < 16; ++i) { LAS float* d = scr + (4 * i + lr) * 65 + lc; d[0] = v[i][0] * g[i]; d[1] = v[i][1] * g[i]; d[2] = v[i][2] * g[i]; d[3] = v[i][3] * g[i]; }
    LDS_WAIT(); asm volatile("" ::: "memory");
    const int c = lane & 7;
#pragma unroll
    for (int j = 0; j < 8; ++j) { const int n = (lane >> 3) + 8 * j; const LAS float* s = scr + (8 * c) * 65 + n;
        u32x4 o; o.x = pk2(s[0 * 65], s[1 * 65]); o.y = pk2(s[2 * 65], s[3 * 65]); o.z = pk2(s[4 * 65], s[5 * 65]); o.w = pk2(s[6 * 65], s[7 * 65]);
        gst<u32x4>(I.WT + (size_t)(I.dest_row0 + n) * I.K + I.k0 + 8 * c, o); }
    LDS_WAIT(); asm volatile("" ::: "memory");
}

__device__ __forceinline__ void p0_prologue(KArgs a, unsigned char* ws, LAS unsigned char* lds, int wave, int lane, int bx) {
    LAS float* scr = (LAS float*)(lds + wave * 16640);
    const int gw = bx * NWAVES + wave, NGW = gridDim.x * NWAVES;
    constexpr int I_FI = (D / 64) * (2 * FF / 64), I_FO = (FF / 64) * (D / 64), I_MI = (D / 64) * (5120 / 64), I_MO = (D / 64) * (D / 64);
    constexpr int NITEMS = 2 * (I_FI + I_FO) + I_MI + I_MO;
    {
        int it = gw;
        if (it < NITEMS) {
            P0Item cur = p0_decode(a, ws, it); f32x4 va[16]; float ga[16];
            p0_load(cur, lane, va, ga);
            for (;;) {
                const int nit = it + NGW; const bool has = nit < NITEMS;
                P0Item nxt = cur; f32x4 vb[16]; float gb[16];
                if (has) { nxt = p0_decode(a, ws, nit); p0_load(nxt, lane, vb, gb); }
                p0_finish(cur, scr, lane, va, ga);
                if (!has) break;
                cur = nxt; it = nit;
#pragma unroll
                for (int i = 0; i < 16; ++i) { va[i] = vb[i]; ga[i] = gb[i]; }
            }
        }
    }
    float* ssx = (float*)(ws + WS_SS);
    for (int m0 = gw; m0 < M; m0 += 4 * NGW) {
        int mr[4]; f32x4 v[4][8];
#pragma unroll
        for (int q = 0; q < 4; ++q) { mr[q] = (m0 + q * NGW < M) ? m0 + q * NGW : m0;
#pragma unroll
            for (int j = 0; j < 8; ++j) v[q][j] = gld_nt<f32x4>((const f32x4*)(a->in[0] + (size_t)mr[q] * D) + lane + 64 * j); }
#pragma unroll
        for (int q = 0; q < 4; ++q) {
            float s = 0.f;
#pragma unroll
            for (int j = 0; j < 8; ++j) s += (v[q][j][0] * v[q][j][0] + v[q][j][1] * v[q][j][1]) + (v[q][j][2] * v[q][j][2] + v[q][j][3] * v[q][j][3]);
            s = wave_sum(s);
            if (q == 0 || mr[q] != m0) {
                if (lane == 0) gst<float>(ssx + mr[q], s);
                u32x2* o8 = (u32x2*)((bf16_t*)(ws + WS_HB) + (size_t)mr[q] * D) + lane;
#pragma unroll
                for (int j = 0; j < 8; ++j) { u32x2 p; p.x = pk2(v[q][j][0], v[q][j][1]); p.y = pk2(v[q][j][2], v[q][j][3]); gst<u32x2>(o8 + 64 * j, p); }
            }
        }
    }
    const int gt = bx * (NWAVES * 64) + wave * 64 + lane, NGT = gridDim.x * NWAVES * 64;
    { float* z = (float*)(ws + WS_SS) + 16384; for (int i = gt; i < 5 * 16384; i += NGT) gst<float>(z + i, 0.f); }
    { float* sp8 = (float*)(ws + WS_SP8); for (int i = gt; i < 2048; i += NGT) gst<float>(sp8 + i, 8.0f * 1.44269504089f * log1pf(expf(-gld<float>(a->in[10] + i)))); }
    {
        const float* gw_ = a->in[8]; u32x4* gwp = (u32x4*)(ws + WS_GWP);
        for (int idx = gt; idx < 32768; idx += NGT) {
            const int ln = idx & 63, ks = (idx >> 6) & 1, jb = (idx >> 7) & 3, g = (idx >> 9) & 1, z = (idx >> 10) & 1, h = idx >> 11;
            const int fr = ln & 15, fq = ln >> 4; float v[8];
#pragma unroll
            for (int s = 0; s < 8; ++s) { const int i = 16 * (2 * ks + (s >> 2)) + 4 * fq + (s & 3), j = 16 * jb + fr; v[s] = -1.44269504089f * gld<float>(gw_ + ((size_t)(((z * 2 + g) * 16 + h) * 64 + i)) * 64 + j); }
            u32x4 w; w.x = pk2(v[0], v[1]); w.y = pk2(v[2], v[3]); w.z = pk2(v[4], v[5]); w.w = pk2(v[6], v[7]); gst<u32x4>(gwp + idx, w);
        }
    }
}

__device__ __forceinline__ float sigm(float x) { return __builtin_amdgcn_rcpf(1.0f + __builtin_amdgcn_exp2f(x * -1.44269504089f)); }
template <int CTRL> __device__ __forceinline__ float dpp_f(float old, float src) {
    return __builtin_bit_cast(float, __builtin_amdgcn_update_dpp(__builtin_bit_cast(int, old), __builtin_bit_cast(int, src), CTRL, 0xF, 0xF, false));
}
template <int DIR, int DD> __device__ __forceinline__ void scan_step(float& av, float& bv) {
    constexpr int CTRL = (DIR == 0 ? 0x110 : 0x100) + DD;
    const float bp = dpp_f<CTRL>(0.0f, bv), ap = dpp_f<CTRL>(1.0f, av);
    bv = av * bp + bv; av = av * ap;
}
__device__ __forceinline__ float neg_expm1(float x) {
    const float p = -x * (1.0f + x * 0.5f * (1.0f + x * (1.0f / 3.0f) * (1.0f + x * 0.25f * (1.0f + x * 0.2f * (1.0f + x * (1.0f / 6.0f))))));
    return x > -0.3f ? p : 1.0f - __expf(x);
}
struct LruCtx { const bf16_t* xl; const bf16_t* gl; const float* convw; const float* convb; const u32x4* gwp; const float* gateb; const float* sp8; float* aggA; float* aggB; bf16_t* y; float* ssA; };

constexpr int L_GWP = 0, L_CW = 32768, L_CB = 33792, L_GB = 34048, L_SP = 35072, L_HF = 36864, L_HF_WAVE = 8192, L_RPB = 102400;
constexpr int XT_ROWB = 144, XT_TILE = 3584, L_XT2 = 102400, L_XT2_WAVE = 7168;
static_assert(L_XT2 + NWAVES * L_XT2_WAVE <= L_BARST && 2 * XT_TILE <= L_XT2_WAVE && 2 * XT_TILE <= L_HF_WAVE, "LDS map (x tiles)");
static_assert(L_HF + NWAVES * L_HF_WAVE == L_RPB && L_RPB + 16 * 15 * 32 * 4 <= LDS_BYTES, "LDS map");
__device__ __forceinline__ void lru_stage_consts(const LruCtx& C, LAS unsigned char* lds, int h, int tid) {
    LAS u32x4* g = (LAS u32x4*)(lds + L_GWP);
    for (int i = tid; i < 2048; i += NWAVES * 64) g[i] = gld<u32x4>(C.gwp + (size_t)h * 2048 + i);
    LAS float* cw = (LAS float*)(lds + L_CW); LAS float* cb = (LAS float*)(lds + L_CB); LAS float* gb = (LAS float*)(lds + L_GB); LAS float* sp = (LAS float*)(lds + L_SP);
    if (tid < 256) cw[tid] = gld<float>(C.convw + (tid >> 6) * LW + h * 64 + (tid & 63));
    if (tid < 64) cb[tid] = gld<float>(C.convb + h * 64 + tid);
    if (tid < 256) gb[tid] = -1.44269504089f * gld<float>(C.gateb + ((tid >> 6) * 16 + h) * 64 + (tid & 63));
    if (tid < 128) sp[tid] = gld<float>(C.sp8 + (tid >> 6) * LW + h * 64 + (tid & 63));
}
struct XRegs { u32x4 v[3]; };
__device__ __forceinline__ void lru_ldx(XRegs& R, const LruCtx& C, int b, int h, int s0, int lane) {
#pragma unroll
    for (int i = 0; i < 3; ++i) { const int s = s0 - 2 + 8 * i + (lane >> 3); const bool ok = (s >= 0) && (s < SEQ);
        const u32x4 v = gld<u32x4>(C.xl + ((size_t)(b * SEQ + (ok ? s : s0))) * LW + h * 64 + (lane & 7) * 8);
        R.v[i] = ok ? v : (u32x4){0u, 0u, 0u, 0u}; }
}
__device__ __forceinline__ void lru_stx(const XRegs& R, int lane, LAS unsigned char* xt) {
#pragma unroll
    for (int i = 0; i < 3; ++i) *(LAS u32x4*)(xt + (8 * i + (lane >> 3)) * XT_ROWB + (lane & 7) * 16) = R.v[i];
}
struct ConvRegs { f32x4 w[4]; f32x4 b; u32x2 x[4]; };
struct GateRegs { u32x4 g[4]; f32x4 br, bi, sp; u32x2 hf; };
__device__ __forceinline__ void ld_conv(ConvRegs& R, const LAS float* cw, const LAS float* cb, const LAS unsigned char* xrow, int jb) {
    R.b = *(const LAS f32x4*)(cb + 16 * jb);
#pragma unroll
    for (int tap = 0; tap < 4; ++tap) { R.w[tap] = *(const LAS f32x4*)(cw + tap * 64 + 16 * jb); R.x[tap] = *(const LAS u32x2*)(xrow + tap * XT_ROWB + 32 * jb); }
}
template <bool WITH_HF>
__device__ __forceinline__ void ld_gate(GateRegs& R, const LAS u32x4* gw, const LAS float* gb, const LAS float* sp_, const LAS unsigned* hfl, int hidx, int jb) {
    R.g[0] = gw[(0 * 4 + jb) * 2 * 64]; R.g[1] = gw[(0 * 4 + jb) * 2 * 64 + 64]; R.g[2] = gw[(1 * 4 + jb) * 2 * 64]; R.g[3] = gw[(1 * 4 + jb) * 2 * 64 + 64];
    R.br = *(const LAS f32x4*)(gb + 16 * jb); R.bi = *(const LAS f32x4*)(gb + 64 + 16 * jb); R.sp = *(const LAS f32x4*)(sp_ + 16 * jb);
    if (WITH_HF) { R.hf.x = hfl[hidx + (jb * 2 + 0) * 64]; R.hf.y = hfl[hidx + (jb * 2 + 1) * 64]; }
}
template <int PASS, int DIR, int MODE>
__device__ __forceinline__ void lru_step(const LruCtx& C, const LAS unsigned char* cst, const LAS unsigned char* xt, int b, int h, int chunk, int tbi, int lane, float (&carry)[4][4], float (&atot)[4][4], LAS unsigned* hfl) {
    const int fr = lane & 15, fq = lane >> 4;
    const int s_tok = chunk * 64 + tbi * 16 + fr;
    const size_t rowoff = ((size_t)(b * SEQ + s_tok)) * LW + h * 64 + 4 * fq;
    u32x2 gr[4];
    if (PASS == 2 && MODE == 1) {
#pragma unroll
        for (int jb = 0; jb < 4; ++jb) gr[jb] = gld<u32x2>(C.gl + rowoff + 16 * jb);
    }
    const LAS unsigned char* xrow = xt + fr * XT_ROWB + 8 * fq;
    const LAS float* cw = (const LAS float*)(cst + L_CW) + 4 * fq; const LAS float* cb = (const LAS float*)(cst + L_CB) + 4 * fq;
    const LAS float* gb = (const LAS float*)(cst + L_GB) + (DIR * 2) * 64 + 4 * fq; const LAS float* sp_ = (const LAS float*)(cst + L_SP) + DIR * 64 + 4 * fq;
    const LAS u32x4* gw = (const LAS u32x4*)(cst + L_GWP) + (size_t)(DIR * 2) * 8 * 64 + lane;
    float xc[4][4];
    {
        ConvRegs ca; ld_conv(ca, cw, cb, xrow, 0);
#pragma unroll
        for (int jb = 0; jb < 4; ++jb) {
            ConvRegs cn; if (jb < 3) ld_conv(cn, cw, cb, xrow, jb + 1);
            SCHED_FENCE();
            f32x4 av = ca.b;
#pragma unroll
            for (int tap = 0; tap < 4; ++tap) { const u32x2 raw = ca.x[tap]; av = av + ca.w[tap] * (f32x4){bf_lo(raw.x), bf_hi(raw.x), bf_lo(raw.y), bf_hi(raw.y)}; }
#pragma unroll
            for (int e = 0; e < 4; ++e) xc[jb][e] = av[e];
            SCHED_FENCE();
            if (jb < 3) ca = cn;
        }
    }
    const bf16x8 xb0 = mk8(xc[0][0], xc[0][1], xc[0][2], xc[0][3], xc[1][0], xc[1][1], xc[1][2], xc[1][3]);
    const bf16x8 xb1 = mk8(xc[2][0], xc[2][1], xc[2][2], xc[2][3], xc[3][0], xc[3][1], xc[3][2], xc[3][3]);
    float ssq = 0.f;
    constexpr bool WHF = (PASS == 2 && MODE == 1);
    const int hidx = tbi * 8 * 64 + lane;
    GateRegs ga; ld_gate<WHF>(ga, gw, gb, sp_, hfl, hidx, 0);
#pragma unroll
    for (int jb = 0; jb < 4; ++jb) {
        GateRegs gn; if (jb < 3) ld_gate<WHF>(gn, gw, gb, sp_, hfl, hidx, jb + 1);
        SCHED_FENCE();
        const f32x4 sp = ga.sp;
        f32x4 ar = ga.br, ai = ga.bi;
        ar = MFMA16(__builtin_bit_cast(bf16x8, ga.g[0]), xb0, ar); ar = MFMA16(__builtin_bit_cast(bf16x8, ga.g[1]), xb1, ar);
        ai = MFMA16(__builtin_bit_cast(bf16x8, ga.g[2]), xb0, ai); ai = MFMA16(__builtin_bit_cast(bf16x8, ga.g[3]), xb1, ai);
        float hv[4];
#pragma unroll
        for (int e = 0; e < 4; ++e) {
            const float rg = __builtin_amdgcn_rcpf(1.0f + __builtin_amdgcn_exp2f(ar[e])), ig = __builtin_amdgcn_rcpf(1.0f + __builtin_amdgcn_exp2f(ai[e]));
            float av = __builtin_amdgcn_exp2f(-rg * sp[e]);
            float bv = __builtin_amdgcn_sqrtf(fmaxf(1.0f - av * av, 0.0f)) * (ig * xc[jb][e]);
            scan_step<DIR, 1>(av, bv); scan_step<DIR, 2>(av, bv); scan_step<DIR, 4>(av, bv); scan_step<DIR, 8>(av, bv);
            hv[e] = bv + av * carry[jb][e];
            carry[jb][e] = dpp_f<(DIR == 0 ? 0x15F : 0x150)>(0.0f, hv[e]);
            if (PASS == 1) atot[jb][e] = atot[jb][e] * dpp_f<(DIR == 0 ? 0x15F : 0x150)>(1.0f, av);
        }
        if (PASS == 2 && MODE == 0) { hfl[(tbi * 8 + jb * 2 + 0) * 64 + lane] = pk2(hv[0], hv[1]); hfl[(tbi * 8 + jb * 2 + 1) * 64 + lane] = pk2(hv[2], hv[3]); }
        if (PASS == 2 && MODE == 1) {
            const unsigned h01 = ga.hf.x, h23 = ga.hf.y;
            const float ho[4] = {bf_lo(h01), bf_hi(h01), bf_lo(h23), bf_hi(h23)};
            const float gvv[4] = {bf_lo(gr[jb].x), bf_hi(gr[jb].x), bf_lo(gr[jb].y), bf_hi(gr[jb].y)};
            float yo[4];
#pragma unroll
            for (int e = 0; e < 4; ++e) { const float g = gvv[e]; const float ge = g * sigm(1.5957691216f * (g + 0.044715f * g * g * g)); yo[e] = ge * (ho[e] + hv[e]); ssq += yo[e] * yo[e]; }
            u32x2 w; w.x = pk2(yo[0], yo[1]); w.y = pk2(yo[2], yo[3]);
            gst<u32x2>(C.y + ((size_t)(b * SEQ + s_tok)) * D + h * 64 + 16 * jb + 4 * fq, w);
        }
        SCHED_FENCE();
        if (jb < 3) ga = gn;
    }
    if (PASS == 2 && MODE == 1) { ssq += __shfl_xor(ssq, 16); ssq += __shfl_xor(ssq, 32); if (fq == 0) gatomic_add(C.ssA + b * SEQ + s_tok, ssq); }
}

template <int DIR>
__device__ __forceinline__ void lru_carry_in(const LruCtx& C, int b, int h, int chunk, int lane, float (&carry)[4][4]) {
    const int fr = lane & 15, fq = lane >> 4;
    const int n = DIR == 0 ? chunk : 31 - chunk;
    const int k0 = 2 * fr, k1 = 2 * fr + 1;
    const int c0 = DIR == 0 ? k0 : 31 - k0, c1 = DIR == 0 ? k1 : 31 - k1;
    const bool ok0 = k0 < n, ok1 = k1 < n;
    const size_t o0 = ((size_t)((DIR * NB + b) * 32 + (ok0 ? c0 : chunk))) * LW + h * 64 + 4 * fq, o1 = ((size_t)((DIR * NB + b) * 32 + (ok1 ? c1 : chunk))) * LW + h * 64 + 4 * fq;
#pragma unroll
    for (int jh = 0; jh < 2; ++jh) {
        f32x4 A0[2], B0[2], A1[2], B1[2];
#pragma unroll
        for (int j2 = 0; j2 < 2; ++j2) { const int jb = 2 * jh + j2; A0[j2] = gld<f32x4>(C.aggA + o0 + 16 * jb); B0[j2] = gld<f32x4>(C.aggB + o0 + 16 * jb); A1[j2] = gld<f32x4>(C.aggA + o1 + 16 * jb); B1[j2] = gld<f32x4>(C.aggB + o1 + 16 * jb); }
        SCHED_FENCE();
#pragma unroll
        for (int j2 = 0; j2 < 2; ++j2)
#pragma unroll
            for (int e = 0; e < 4; ++e) {
                const int jb = 2 * jh + j2;
                const float a0 = ok0 ? A0[j2][e] : 1.0f, b0 = ok0 ? B0[j2][e] : 0.0f, a1 = ok1 ? A1[j2][e] : 1.0f, b1 = ok1 ? B1[j2][e] : 0.0f;
                float av = a0 * a1, bv = a1 * b0 + b1;
                scan_step<0, 1>(av, bv); scan_step<0, 2>(av, bv); scan_step<0, 4>(av, bv); scan_step<0, 8>(av, bv);
                carry[jb][e] = dpp_f<0x15F>(0.0f, bv);
            }
        SCHED_FENCE();
    }
}
template <int PASS>
__device__ __forceinline__ void lru_unit(const LruCtx& C, int b, int h, int chunk, int lane, const LAS unsigned char* cst_, LAS unsigned char* wl, LAS unsigned char* xt) {
    const int fr = lane & 15, fq = lane >> 4;
    LAS unsigned* hfl = (LAS unsigned*)wl;
    float cf[4][4], cb[4][4], af[4][4], ab[4][4];
#pragma unroll
    for (int jb = 0; jb < 4; ++jb)
#pragma unroll
        for (int e = 0; e < 4; ++e) { cf[jb][e] = 0.f; cb[jb][e] = 0.f; af[jb][e] = 1.f; ab[jb][e] = 1.f; }
    if (PASS == 2) { lru_carry_in<0>(C, b, h, chunk, lane, cf); lru_carry_in<1>(C, b, h, chunk, lane, cb); }
    unsigned co = 0;
    if (PASS == 1) {
        XRegs x0, x1; lru_ldx(x0, C, b, h, chunk * 64, lane); lru_ldx(x1, C, b, h, chunk * 64 + 48, lane);
#pragma unroll 1
        for (int t = 0; t < 4; ++t) {
            asm volatile("" : "+s"(co));
            const LAS unsigned char* cst = cst_ + co;
            lru_stx(x0, lane, xt); lru_stx(x1, lane, xt + XT_TILE);
            { const int tn = t < 3 ? t + 1 : 3; lru_ldx(x0, C, b, h, chunk * 64 + tn * 16, lane); lru_ldx(x1, C, b, h, chunk * 64 + (3 - tn) * 16, lane); }
            SCHED_FENCE();
            lru_step<1, 0, 0>(C, cst, xt, b, h, chunk, t, lane, cf, af, hfl);
            lru_step<1, 1, 0>(C, cst, xt + XT_TILE, b, h, chunk, 3 - t, lane, cb, ab, hfl);
        }
        if (fr == 0) {
            const size_t o0 = ((size_t)((0 * NB + b) * 32 + chunk)) * LW + h * 64 + 4 * fq, o1 = ((size_t)((1 * NB + b) * 32 + chunk)) * LW + h * 64 + 4 * fq;
#pragma unroll
            for (int jb = 0; jb < 4; ++jb) {
                gst<f32x4>(C.aggA + o0 + 16 * jb, (f32x4){af[jb][0], af[jb][1], af[jb][2], af[jb][3]}); gst<f32x4>(C.aggB + o0 + 16 * jb, (f32x4){cf[jb][0], cf[jb][1], cf[jb][2], cf[jb][3]});
                gst<f32x4>(C.aggA + o1 + 16 * jb, (f32x4){ab[jb][0], ab[jb][1], ab[jb][2], ab[jb][3]}); gst<f32x4>(C.aggB + o1 + 16 * jb, (f32x4){cb[jb][0], cb[jb][1], cb[jb][2], cb[jb][3]});
            }
        }
    } else {
        XRegs x0, x1; lru_ldx(x0, C, b, h, chunk * 64, lane); lru_ldx(x1, C, b, h, chunk * 64 + 48, lane);
#pragma unroll 1
        for (int t = 0; t < 2; ++t) {
            asm volatile("" : "+s"(co));
            const LAS unsigned char* cst = cst_ + co;
            lru_stx(x0, lane, xt); lru_stx(x1, lane, xt + XT_TILE);
            lru_ldx(x0, C, b, h, chunk * 64 + (t + 1) * 16, lane); lru_ldx(x1, C, b, h, chunk * 64 + (2 - t) * 16, lane);
            SCHED_FENCE();
            lru_step<2, 0, 0>(C, cst, xt, b, h, chunk, t, lane, cf, af, hfl);
            SCHED_FENCE();
            lru_step<2, 1, 0>(C, cst, xt + XT_TILE, b, h, chunk, 3 - t, lane, cb, ab, hfl);
        }
#pragma unroll 1
        for (int t = 2; t < 4; ++t) {
            asm volatile("" : "+s"(co));
            const LAS unsigned char* cst = cst_ + co;
            lru_stx(x0, lane, xt); lru_stx(x1, lane, xt + XT_TILE);
            lru_ldx(x0, C, b, h, chunk * 64 + 48, lane); lru_ldx(x1, C, b, h, chunk * 64, lane);
            SCHED_FENCE();
            lru_step<2, 0, 1>(C, cst, xt, b, h, chunk, t, lane, cf, af, hfl);
            SCHED_FENCE();
            lru_step<2, 1, 1>(C, cst, xt + XT_TILE, b, h, chunk, 3 - t, lane, cb, ab, hfl);
        }
    }
}
template <int PASS>
__device__ __forceinline__ void lru_phase(const LruCtx& C, LAS unsigned char* lds, int wave, int lane, int G, int bx) {
    const int h = bx & 15, jblk = bx >> 4, nblk = G >> 4;
    for (int combo = jblk * NWAVES + wave; combo < 256; combo += nblk * NWAVES) lru_unit<PASS>(C, combo >> 5, h, combo & 31, lane, lds, lds + L_HF + wave * L_HF_WAVE, PASS == 1 ? lds + L_HF + wave * L_HF_WAVE : lds + L_XT2 + wave * L_XT2_WAVE);
}

struct AttnCtx { const bf16_t* q; const bf16_t* k; const bf16_t* vT; const LAS float* rpb; bf16_t* y; float* ssB; };
__device__ __forceinline__ void attn_unit(const AttnCtx& C, int unit, int lane) {
    const int j = unit & 3, h = (unit >> 2) & 15, r = (unit >> 6) & 31, b = unit >> 11;
    const int fr = lane & 15, fq = lane >> 4;
    const int rs = min(max(r - 4, 0), 24), kc0 = min(max(16 * j - 8, 0), 32);
    const int qcol = 16 * j + fr, cs = min(max(qcol - 8, 0), 48);
    const size_t tq = (size_t)b * SEQ + r * 64 + qcol;
    const bf16x8 q0 = gld<bf16x8>(C.q + tq * LW + h * 64 + 8 * fq), q1 = gld<bf16x8>(C.q + tq * LW + h * 64 + 32 + 8 * fq);
    const bf16_t* kbase = C.k + (((size_t)(b * 16 + h) * 2) * SEQ + rs * 64 + kc0 + 8 * (fr >> 2) + (fr & 3)) * 32 + 8 * fq;
    const LAS float* bias_base = C.rpb + (h * 15 + (rs - r + 7)) * 32;
    float sv[8][8];
    float mx = -INFINITY;
    f32x4 o[4];
    {
        bf16x8 kf[8][2][2];
#pragma unroll
        for (int rr = 0; rr < 8; ++rr)
#pragma unroll
            for (int p = 0; p < 2; ++p) { const bf16_t* kp = kbase + (size_t)(rr * 64 + 4 * p) * 32; kf[rr][p][0] = gld<bf16x8>(kp); kf[rr][p][1] = gld<bf16x8>(kp + (size_t)SEQ * 32); }
        SCHED_FENCE();
#pragma unroll
        for (int rr = 0; rr < 8; ++rr) {
#pragma unroll
            for (int p = 0; p < 2; ++p) {
                f32x4 acc = (f32x4){0.f, 0.f, 0.f, 0.f};
                acc = MFMA16(kf[rr][p][0], q0, acc); acc = MFMA16(kf[rr][p][1], q1, acc);
#pragma unroll
                for (int e = 0; e < 4; ++e) {
                    const int kcol = kc0 + 8 * fq + 4 * p + e;
                    const bool valid = (kcol >= cs) && (kcol < cs + 16);
                    const int bi = min(max(kcol - qcol + 15, 0), 30);
                    const float bz = bias_base[rr * 32 + bi];
                    const float v = (acc[e] + bz) + (valid ? 0.0f : -INFINITY);
                    sv[rr][4 * p + e] = v; mx = fmaxf(mx, v);
                }
            }
        }
        SCHED_FENCE();
    }
    {
        bf16x8 vf[8][4];
        const bf16_t* vbase = C.vT + ((((size_t)((b * 16 + h) * 32 + rs)) * 8 + (kc0 >> 3) + fq) * 64 + fr) * 8;
#pragma unroll
        for (int rr = 0; rr < 8; ++rr)
#pragma unroll
            for (int d = 0; d < 4; ++d) vf[rr][d] = gld<bf16x8>(vbase + (size_t)rr * (8 * 64 * 8) + d * (16 * 8));
        SCHED_FENCE();
        mx = fmaxf(mx, __shfl_xor(mx, 16)); mx = fmaxf(mx, __shfl_xor(mx, 32));
        float sum_ = 0.f;
#pragma unroll
        for (int rr = 0; rr < 8; ++rr)
#pragma unroll
            for (int i = 0; i < 8; ++i) { const float p = __builtin_amdgcn_exp2f(sv[rr][i] - mx); sv[rr][i] = p; sum_ += p; }
        sum_ += __shfl_xor(sum_, 16); sum_ += __shfl_xor(sum_, 32);
        sv[0][0] = sv[0][0];
        SCHED_FENCE();
#pragma unroll
        for (int d = 0; d < 4; ++d) o[d] = (f32x4){0.f, 0.f, 0.f, 0.f};
#pragma unroll
        for (int rr = 0; rr < 8; ++rr) {
            const bf16x8 pf = mk8(sv[rr][0], sv[rr][1], sv[rr][2], sv[rr][3], sv[rr][4], sv[rr][5], sv[rr][6], sv[rr][7]);
#pragma unroll
            for (int d = 0; d < 4; ++d) o[d] = MFMA16(vf[rr][d], pf, o[d]);
        }
        mx = sum_;
    }
    const float sum = mx;
    const float inv = __builtin_amdgcn_rcpf(sum); float ssq = 0.f;
#pragma unroll
    for (int d = 0; d < 4; ++d) {
        const f32x4 ov = o[d] * inv; ssq += (ov[0] * ov[0] + ov[1] * ov[1]) + (ov[2] * ov[2] + ov[3] * ov[3]);
        u32x2 w; w.x = pk2(ov[0], ov[1]); w.y = pk2(ov[2], ov[3]);
        gst<u32x2>(C.y + tq * D + LW + h * 64 + 16 * d + 4 * fq, w);
    }
    ssq += __shfl_xor(ssq, 16); ssq += __shfl_xor(ssq, 32);
    if (fq == 0) gatomic_add(C.ssB + tq, ssq);
}

__global__ void __launch_bounds__(NWAVES * 64, 2) mk_fwd(Args args) {
    extern __shared__ __attribute__((aligned(16))) unsigned char lds_raw[];
    LAS unsigned char* lds = (LAS unsigned char*)lds_raw;
    KArgs ka0 = (KArgs)__builtin_amdgcn_kernarg_segment_ptr();
    const int ph_lo = ka0->ph_lo, ph_hi = ka0->ph_hi, coop = ka0->coop;
    const int wave0 = __builtin_amdgcn_readfirstlane((int)(threadIdx.x >> 6));
    if (threadIdx.x < 2) ((volatile LAS unsigned*)(lds + L_BARST))[threadIdx.x] = 0u;
    __syncthreads();
    XcdBarrier bar; bar.bar = (unsigned*)(ka0->ws + WS_BAR); bar.x = 0; bar.st = (volatile LAS unsigned*)(lds + L_BARST);
    if (coop == 1) bar = xcd_barrier_post((unsigned*)(ka0->ws + WS_BAR), (volatile LAS unsigned*)(lds + L_BARST), (int)threadIdx.x);
    for (int ph = ph_lo; ph < ph_hi; ++ph) {
        KArgs ka = ka0; asm volatile("" : "+s"(ka));
        int lane_ = (int)__builtin_amdgcn_mbcnt_hi(~0u, __builtin_amdgcn_mbcnt_lo(~0u, 0u)); asm volatile("" : "+v"(lane_));
        int tid = wave0 * 64 + lane_;
        unsigned char* ws = ka->ws; asm volatile("" : "+s"(ws));
        int wave = wave0, bx = (int)blockIdx.x; asm volatile("" : "+s"(wave), "+s"(bx));
        const int lane = lane_ & 63;
        float* SS = (float*)(ws + WS_SS);
        float *ssx = SS, *ssh1 = SS + 16384, *ssA = SS + 2 * 16384, *ssB = SS + 3 * 16384, *ssh2 = SS + 4 * 16384, *ssh3 = SS + 5 * 16384;
        bf16_t* HB = (bf16_t*)(ws + WS_HB); bf16_t* Y = (bf16_t*)(ws + WS_Y); bf16_t* ACT = (bf16_t*)(ws + WS_ACT);
        const int G = gridDim.x, gw = bx * NWAVES + wave, NGW = G * NWAVES;
        if (ph == 0) {
            p0_prologue(ka, ws, lds, wave, lane, bx);
        } else if (ph == 1 || ph == 8) {
            const bool f1 = (ph == 1);
            pg8::Gemm g{HB, (const bf16_t*)(ws + (f1 ? WS_W1I : WS_W2I)), M, 2 * FF, D}; pg8::StaticOrder S; S.init(M, 2 * FF, G, bx);
            pg8::EpiSwiGLU E{f1 ? ssx : ssh2, ACT, FF};
#if !defined(NO_GEMM) && !defined(NO_G1)
            pg8::gemm_phase<pg8::EpiSwiGLU, pg8::StaticOrder, true, true>(lds, g, S, E, tid);
#endif
        } else if (ph == 2 || ph == 9) {
            const bf16_t* Bt = (const bf16_t*)(ws + (ph == 2 ? WS_W1O : WS_W2O));
            pg8::Gemm g{ACT, Bt, M, D, FF}; pg8::StaticOrder S; S.init(M, D, G, bx);
            pg8::EpiResid<false> E{ph == 2 ? ka->in[0] : (const float*)nullptr, HB, ph == 2 ? ssh1 : ssh3, 0.5f, nullptr, nullptr};
            pg8::gemm_phase<pg8::EpiResid<false>, pg8::StaticOrder, true, true>(lds, g, S, E, tid);
        } else if (ph == 7) {
            pg8::Gemm g{Y, (const bf16_t*)(ws + WS_WMO), M, D, D}; pg8::StaticOrder S; S.init(M, D, G, bx);
            pg8::EpiResid<true> E{(const float*)nullptr, HB, ssh2, 1.0f, ssA, ssB};
            pg8::gemm_phase<pg8::EpiResid<true>, pg8::StaticOrder, true, true>(lds, g, S, E, tid);
        } else if (ph == 3) {
            { pg8::Gemm g{HB, (const bf16_t*)(ws + WS_WMI), M, 4096, D}; pg8::StaticOrder S; S.init(M, 4096, G, bx);
              pg8::EpiProj E{ssh1, ACT};
#if !defined(NO_GEMM) && !defined(NO_G3)
              pg8::gemm_phase<pg8::EpiProj, pg8::StaticOrder, true, true>(lds, g, S, E, tid);
#endif
            }
            { pg8::Gemm g{(const bf16_t*)(ws + WS_WMI) + (size_t)4096 * D, HB, 1024, M, D}; pg8::StaticOrder S; S.init(1024, M, G, bx);
              pg8::EpiVT E{ssh1, ACT + 4 * (size_t)M * LW};
#if !defined(NO_GEMM) && !defined(NO_G4)
              pg8::gemm_phase<pg8::EpiVT, pg8::StaticOrder, true, true>(lds, g, S, E, tid);
#endif
            }
        } else if (ph == 4 || ph == 5) {
            const size_t SEG = (size_t)M * LW;
            LruCtx C{ACT, ACT + SEG, ka->in[6], ka->in[7], (const u32x4*)(ws + WS_GWP), ka->in[9], (const float*)(ws + WS_SP8), (float*)(ws + WS_AGG), (float*)(ws + WS_AGG + 2 * MiB), Y, ssA};
            if (ph == 4 || coop != 1 || ph_lo > 4) lru_stage_consts(C, lds, bx & 15, tid);
            if (ph == 4) {
                { LAS float* tab = (LAS float*)(lds + L_RPB); const float* rpb = ka->in[11];
                  for (int i = tid; i < 16 * 15 * 32; i += NWAVES * 64) { const int rw = i >> 5, c = i & 31; tab[i] = c < 31 ? 1.44269504089f * gld<float>(rpb + rw * 31 + c) : 0.f; } }
                __syncthreads();
                for (int step = 0; step < 2; ++step) {
                    const bool do_lru = (step == 0) == (wave < 4);
                    int lane_s = lane; asm volatile("" : "+v"(lane_s));
                    if (do_lru) { lru_phase<1>(C, lds, wave, lane_s, G, bx); }
                    else {
                        AttnCtx A{ACT + 2 * SEG, ACT + 3 * SEG, ACT + 4 * SEG, (const LAS float*)(lds + L_RPB), Y, ssB};
                        if (G == 256) {
                            for (int i = 0; i < 8; ++i) attn_unit(A, ((bx & 7) << 11) | (i * 256 + (bx >> 3) * 8 + wave), lane_s);
                        } else { for (int u = gw; u < 16384; u += NGW) attn_unit(A, u, lane_s); }
                    }
                    asm volatile("" : "+v"(tid));
                }
            } else {
                __syncthreads();
                lru_phase<2>(C, lds, wave, lane, G, bx);
            }
            __syncthreads();
        } else if (ph == 6) {
        } else {
            const float* gF = ka->in[18];
            const f32x4* gr = (const f32x4*)gF + lane;
            for (int m0 = gw; m0 < M; m0 += 4 * NGW) {
                int mr[4]; float ss[4]; u32x2 r[4][8];
#pragma unroll
                for (int q = 0; q < 4; ++q) { mr[q] = (m0 + q * NGW < M) ? m0 + q * NGW : m0; ss[q] = gld<float>(ssh3 + mr[q]); }
#pragma unroll
                for (int q = 0; q < 4; ++q)
#pragma unroll
                    for (int j = 0; j < 8; ++j) r[q][j] = gld_nt<u32x2>((const u32x2*)(HB + (size_t)mr[q] * D) + lane + 64 * j);
#pragma unroll
                for (int j = 0; j < 8; ++j) { const f32x4 g = gld<f32x4>(gr + 64 * j);
#pragma unroll
                    for (int q = 0; q < 4; ++q) if (q == 0 || mr[q] != m0) {
                        const float rs = pg8::rstd_of(ss[q], 1.0f / 2048.0f);
                        gst_nt<f32x4>((f32x4*)(ka->out + (size_t)mr[q] * D) + lane + 64 * j, (f32x4){bf_lo(r[q][j].x), bf_hi(r[q][j].x), bf_lo(r[q][j].y), bf_hi(r[q][j].y)} * g * rs); }
                }
            }
        }
        if (ph + 1 < ph_hi && ph != 6) {
            if (coop == 1) xcd_barrier(bar, tid);
            else if (coop == 2) cg::this_grid().sync();
        }
    }
}

extern "C" void kernel_launch(void* const* d_in, const int* in_sizes, int n_in, void* d_out, int out_size, void* d_ws, size_t ws_size, hipStream_t stream) {
    static int grid = 0;
    if (grid == 0) {
        if (n_in != 19 || out_size != M * D || ws_size < WS_END) { fprintf(stderr, "kernel_launch: unexpected shapes (n_in %d, out %d, ws %zu)\n", n_in, out_size, ws_size); grid = -1; return; }
        int dev = 0, cus = 0, per_cu = 0;
        hipGetDevice(&dev); hipDeviceGetAttribute(&cus, hipDeviceAttributeMultiprocessorCount, dev);
        if (hipFuncSetAttribute((const void*)mk_fwd, hipFuncAttributeMaxDynamicSharedMemorySize, LDS_BYTES) != hipSuccess) { fprintf(stderr, "kernel_launch: hipFuncSetAttribute failed\n"); grid = -1; return; }
        if (hipOccupancyMaxActiveBlocksPerMultiprocessor(&per_cu, (const void*)mk_fwd, NWAVES * 64, LDS_BYTES) != hipSuccess || per_cu < 1) { fprintf(stderr, "kernel_launch: occupancy query says %d\n", per_cu); per_cu = 1; }
        (void)hipGetLastError();
        grid = cus * 1;
        if (grid != 256) fprintf(stderr, "kernel_launch: note: grid %d\n", grid);
    }
    if (grid < 0) return;
    Args a{};
    for (int i = 0; i < 19; ++i) a.in[i] = (const float*)d_in[i];
    a.out = (float*)d_out; a.ws = (unsigned char*)d_ws;
#if MK_COOP
    if (hipMemsetAsync((char*)d_ws + WS_BAR, 0, 16384, stream) != hipSuccess) { fprintf(stderr, "kernel_launch: memset of the barrier words failed\n"); return; }
    a.ph_lo = 0; a.ph_hi = N_PHASES; a.coop = 1;
    void* kargs[] = {&a};
    hipError_t e = hipLaunchCooperativeKernel((const void*)mk_fwd, dim3(grid), dim3(NWAVES * 64), kargs, LDS_BYTES, stream);
    if (e != hipSuccess) fprintf(stderr, "kernel_launch: cooperative launch failed: %s\n", hipGetErrorString(e));
#else
    for (int ph = 0; ph < N_PHASES; ++ph) {
        a.ph_lo = ph; a.ph_hi = ph + 1; a.coop = 0;
        hipLaunchKernelGGL(mk_fwd, dim3(grid), dim3(NWAVES * 64), LDS_BYTES, stream, a);
    }
#endif
}
```
